# Optimizing an MI355X kernel written in HIP

```python
import math
import jax, jax.numpy as jnp
from jax import lax
import numpy as np

D_MODEL = 1024
BATCH = 2
SEQ = 8192
DEPTH = 4

ATT_HEADS = 8
KV_HEADS = 2
GQA_GROUP = ATT_HEADS // KV_HEADS
HEAD_DIM = 64
ATT_WIDTH = ATT_HEADS * HEAD_DIM
KV_WIDTH = KV_HEADS * HEAD_DIM
WINDOW = 128
BLOCK = 128
SSM_WIDTH = D_MODEL - ATT_WIDTH
SSM_GROUP = 16
SSM_GROUPS = SSM_WIDTH // SSM_GROUP
SSM_STATE = 64
DT_MIN = 1e-3
DT_MAX = 1e-1
MIX_WIDTH = ATT_WIDTH + SSM_WIDTH
IN_WIDTH = ATT_WIDTH + 2 * KV_WIDTH + SSM_WIDTH
D_FF = 4 * D_MODEL
EPS = 1e-6

kernel_name = "hymba_style_swa_s5_hybrid_encoder"


def rms_norm(x, gain):
    xf = x.astype(jnp.float32)
    y = xf * lax.rsqrt(jnp.mean(xf * xf, axis=-1, keepdims=True) + EPS)
    return (y * gain.astype(jnp.float32)).astype(x.dtype)


def alibi_slopes(n_heads):
    return jnp.exp2(-8.0 * jnp.arange(1, n_heads + 1, dtype=jnp.float32) / n_heads)


def windowed_gqa(q, k, v, q_gain, k_gain, sink):
    bsz, seq = q.shape[0], q.shape[1]
    nb = seq // BLOCK
    q = rms_norm(q, q_gain)
    k = rms_norm(k, k_gain)
    qb = q.reshape(bsz, nb, BLOCK, KV_HEADS, GQA_GROUP, HEAD_DIM)

    def band(t):
        tp = jnp.pad(t, ((0, 0), (BLOCK, BLOCK), (0, 0), (0, 0)))
        tb = tp.reshape(bsz, nb + 2, BLOCK, KV_HEADS, HEAD_DIM)
        return jnp.concatenate([tb[:, :-2], tb[:, 1:-1], tb[:, 2:]], axis=2)

    kb, vb = band(k), band(v)
    scores = jnp.einsum('bnqkgd,bnckd->bnkgqc', qb, kb,
                        preferred_element_type=jnp.float32) / math.sqrt(HEAD_DIM)
    q_idx = jnp.arange(BLOCK)[:, None]
    c_idx = jnp.arange(3 * BLOCK)[None, :]
    dist = jnp.abs(q_idx - c_idx + BLOCK)
    key_pos = (jnp.arange(nb)[:, None] - 1) * BLOCK + jnp.arange(3 * BLOCK)[None, :]
    valid = (dist <= WINDOW)[None] & ((key_pos >= 0) & (key_pos < seq))[:, None, :]
    slopes = alibi_slopes(ATT_HEADS).reshape(KV_HEADS, GQA_GROUP)
    bias = -slopes[:, :, None, None] * dist.astype(jnp.float32)
    neg = jnp.finfo(jnp.float32).min
    scores = jnp.where(valid[None, :, None, None], scores + bias, neg)
    sk = sink.astype(jnp.float32).reshape(1, 1, KV_HEADS, GQA_GROUP, 1, 1)
    m = jnp.maximum(jnp.max(scores, axis=-1, keepdims=True), sk)
    p = jnp.exp(scores - m)
    denom = jnp.sum(p, axis=-1, keepdims=True) + jnp.exp(sk - m)
    out = jnp.einsum('bnkgqc,bnckd->bnqkgd', (p / denom).astype(v.dtype), vb)
    return out.reshape(bsz, seq, ATT_WIDTH)


def complex_diag_scan(a_re, a_im, b_re, b_im, reverse):
    ar = jnp.broadcast_to(a_re, b_re.shape)
    ai = jnp.broadcast_to(a_im, b_re.shape)

    def combine(e1, e2):
        a1r, a1i, b1r, b1i = e1
        a2r, a2i, b2r, b2i = e2
        return (a1r * a2r - a1i * a2i,
                a1r * a2i + a1i * a2r,
                a2r * b1r - a2i * b1i + b2r,
                a2r * b1i + a2i * b1r + b2i)

    _, _, xr, xi = lax.associative_scan(combine, (ar, ai, b_re, b_im), reverse=reverse, axis=1)
    return xr, xi


def s5_mixer(u, lam_re, lam_im, log_dt, b_re, b_im, c_re, c_im, d_skip, w_glu):
    bsz, seq = u.shape[0], u.shape[1]
    uf = u.astype(jnp.float32).reshape(bsz, seq, SSM_GROUPS, SSM_GROUP)
    y = d_skip.astype(jnp.float32).reshape(SSM_GROUPS, SSM_GROUP) * uf
    br = b_re.astype(jnp.float32)
    bi = b_im.astype(jnp.float32)
    for direction, reverse in enumerate((False, True)):
        lr = lam_re[direction].astype(jnp.float32)
        li = lam_im[direction].astype(jnp.float32)
        dt = jnp.exp(log_dt[direction].astype(jnp.float32))[:, None]
        mag = jnp.exp(lr * dt)
        abr = mag * jnp.cos(li * dt)
        abi = mag * jnp.sin(li * dt)
        den = lr * lr + li * li
        zr = ((abr - 1.0) * lr + abi * li) / den
        zi = (abi * lr - (abr - 1.0) * li) / den
        bbr = zr[..., None] * br - zi[..., None] * bi
        bbi = zr[..., None] * bi + zi[..., None] * br
        bur = jnp.einsum('bsgh,gph->bsgp', uf, bbr)
        bui = jnp.einsum('bsgh,gph->bsgp', uf, bbi)
        xr, xi = complex_diag_scan(abr, abi, bur, bui, reverse)
        y = (y + jnp.einsum('bsgp,ghp->bsgh', xr, c_re[direction].astype(jnp.float32))
             - jnp.einsum('bsgp,ghp->bsgh', xi, c_im[direction].astype(jnp.float32)))
    y = jax.nn.gelu(y).reshape(bsz, seq, SSM_WIDTH).astype(u.dtype)
    g_val, g_gate = jnp.split(y @ w_glu, 2, axis=-1)
    return g_val * jax.nn.sigmoid(g_gate)


def setup_inputs(seed: int = 0) -> dict:
    key = jax.random.key(seed)
    ks = jax.random.split(key, 20)
    nrm = jax.random.normal
    f32 = jnp.float32
    x = nrm(ks[0], (BATCH, SEQ, D_MODEL), f32)
    norm1 = 1.0 + 0.05 * nrm(ks[1], (DEPTH, D_MODEL), f32)
    w_in = nrm(ks[2], (DEPTH, D_MODEL, IN_WIDTH), f32) * D_MODEL ** -0.5
    q_gain = 1.0 + 0.05 * nrm(ks[3], (DEPTH, HEAD_DIM), f32)
    k_gain = 1.0 + 0.05 * nrm(ks[4], (DEPTH, HEAD_DIM), f32)
    sink = 0.5 * nrm(ks[5], (DEPTH, ATT_HEADS), f32)
    lam_re = -0.5 + 0.01 * nrm(ks[6], (DEPTH, 2, SSM_GROUPS, SSM_STATE), f32)
    lam_im = (math.pi * jnp.arange(SSM_STATE, dtype=f32)
              + 0.01 * nrm(ks[7], (DEPTH, 2, SSM_GROUPS, SSM_STATE), f32))
    log_dt = jax.random.uniform(ks[8], (DEPTH, 2, SSM_GROUPS), f32,
                                minval=math.log(DT_MIN), maxval=math.log(DT_MAX))
    b_re = nrm(ks[9], (DEPTH, SSM_GROUPS, SSM_STATE, SSM_GROUP), f32) * (2 * SSM_GROUP) ** -0.5
    b_im = nrm(ks[10], (DEPTH, SSM_GROUPS, SSM_STATE, SSM_GROUP), f32) * (2 * SSM_GROUP) ** -0.5
    c_re = nrm(ks[11], (DEPTH, 2, SSM_GROUPS, SSM_GROUP, SSM_STATE), f32) * SSM_STATE ** -0.5
    c_im = nrm(ks[12], (DEPTH, 2, SSM_GROUPS, SSM_GROUP, SSM_STATE), f32) * SSM_STATE ** -0.5
    d_skip = nrm(ks[13], (DEPTH, SSM_WIDTH), f32)
    w_glu = nrm(ks[14], (DEPTH, SSM_WIDTH, 2 * SSM_WIDTH), f32) * SSM_WIDTH ** -0.5
    w_out = nrm(ks[15], (DEPTH, MIX_WIDTH, D_MODEL), f32) * (0.5 * MIX_WIDTH ** -0.5)
    norm2 = 1.0 + 0.05 * nrm(ks[16], (DEPTH, D_MODEL), f32)
    w_ff1 = nrm(ks[17], (DEPTH, D_MODEL, D_FF), f32) * D_MODEL ** -0.5
    w_ff2 = nrm(ks[18], (DEPTH, D_FF, D_MODEL), f32) * (0.5 * D_FF ** -0.5)
    return {"x": x, "norm1": norm1, "w_in": w_in, "q_gain": q_gain, "k_gain": k_gain,
            "sink": sink, "lam_re": lam_re, "lam_im": lam_im, "log_dt": log_dt,
            "b_re": b_re, "b_im": b_im, "c_re": c_re, "c_im": c_im, "d_skip": d_skip,
            "w_glu": w_glu, "w_out": w_out, "norm2": norm2, "w_ff1": w_ff1, "w_ff2": w_ff2}


def reference(x, norm1, w_in, q_gain, k_gain, sink, lam_re, lam_im, log_dt,
              b_re, b_im, c_re, c_im, d_skip, w_glu, w_out, norm2, w_ff1, w_ff2):
    bsz, seq = x.shape[0], x.shape[1]
    q_end = ATT_WIDTH
    k_end = q_end + KV_WIDTH
    v_end = k_end + KV_WIDTH
    for layer in range(DEPTH):
        h = rms_norm(x, norm1[layer])
        z = h @ w_in[layer]
        q = z[..., :q_end].reshape(bsz, seq, ATT_HEADS, HEAD_DIM)
        k = z[..., q_end:k_end].reshape(bsz, seq, KV_HEADS, HEAD_DIM)
        v = z[..., k_end:v_end].reshape(bsz, seq, KV_HEADS, HEAD_DIM)
        u = z[..., v_end:]
        att = windowed_gqa(q, k, v, q_gain[layer], k_gain[layer], sink[layer])
        ssm = s5_mixer(u, lam_re[layer], lam_im[layer], log_dt[layer], b_re[layer], b_im[layer],
                       c_re[layer], c_im[layer], d_skip[layer], w_glu[layer])
        x = x + jnp.concatenate([att, ssm], axis=-1) @ w_out[layer]
        h = rms_norm(x, norm2[layer])
        x = x + jnp.square(jax.nn.relu(h @ w_ff1[layer])) @ w_ff2[layer]
    return x
```

```cpp
#include <hip/hip_runtime.h>
#include <hip/hip_cooperative_groups.h>
#include <cstdio>
#include <cstdint>
namespace cg = cooperative_groups;

#define LAS __attribute__((address_space(3)))
typedef unsigned short bf16_t;
typedef short bf16x8 __attribute__((ext_vector_type(8)));
typedef short s16x4 __attribute__((ext_vector_type(4)));
typedef float f32x4 __attribute__((ext_vector_type(4)));
typedef float f32x2 __attribute__((ext_vector_type(2)));
typedef float f32x16 __attribute__((ext_vector_type(16)));
typedef unsigned u32x4 __attribute__((ext_vector_type(4)));
typedef unsigned u32x2 __attribute__((ext_vector_type(2)));
typedef __bf16 bf2_t __attribute__((ext_vector_type(2)));

constexpr int NTOK = 16384, SEQ = 8192, DM = 1024, INW = 1280, FF = 4096, DEPTH = 4;
constexpr int CH = 32;
constexpr int NCH = NTOK / CH;
constexpr int UK = CH * 16 + 256;
constexpr float EPS = 1e-6f;
constexpr float LOG2E = 1.4426950408889634f;

constexpr size_t MiB = 1u << 20;
constexpr size_t WS_WIN = 1 * MiB;
constexpr size_t WS_WGLU = WS_WIN + 5 * MiB / 2;
constexpr size_t WS_WOUT = WS_WGLU + 1 * MiB;
constexpr size_t WS_W1 = WS_WOUT + 2 * MiB;
constexpr size_t WS_W2 = WS_W1 + 8 * MiB;
constexpr size_t WS_MST = 24 * MiB;
constexpr size_t WS_TOUT = 32 * MiB;
constexpr size_t WS_XN = 56 * MiB;
constexpr size_t WS_HID = 88 * MiB;
constexpr size_t WS_Q = 88 * MiB;
constexpr size_t WS_K = 104 * MiB;
constexpr size_t WS_V = 108 * MiB;
constexpr size_t WS_UB = 112 * MiB;
constexpr size_t WS_S = 136 * MiB;
constexpr size_t WS_Y = 152 * MiB;
constexpr size_t WS_MIX = 168 * MiB;
constexpr size_t WS_PART = 216 * MiB;
constexpr size_t WS_APOW = 218 * MiB;
constexpr size_t WS_TOUT2 = 220 * MiB;
constexpr size_t WS_MST2 = 244 * MiB;
constexpr size_t WS_WIN2 = 252 * MiB;
constexpr size_t WS_END = 255 * MiB;

constexpr int LDS_BYTES = 147456;
constexpr int REP_SYNC = 1, REP_P0 = 1, REP_P1 = 1, REP_P2 = 1, REP_P4 = 1, REP_P5 = 1, REP_P7 = 1, REP_P0A = 1, REP_P0B = 1, REP_P2A = 1, REP_P2B = 1;
#define GSYNC() do { for (int rs_ = 0; rs_ < REP_SYNC; ++rs_) xcd_barrier(xbar); } while (0)
constexpr size_t WS_FLAG = 32768;
constexpr size_t WS_BAR = 65536;
constexpr int LDS_BARST = LDS_BYTES - 64;

__device__ __forceinline__ unsigned pk2(float lo, float hi) { f32x2 v = {lo, hi}; bf2_t b = __builtin_convertvector(v, bf2_t); return __builtin_bit_cast(unsigned, b); }
__device__ __forceinline__ float bflo(unsigned w) { return __builtin_bit_cast(float, w << 16); }
__device__ __forceinline__ float bfhi(unsigned w) { return __builtin_bit_cast(float, w & 0xffff0000u); }
__device__ __forceinline__ float ex2(float x) { return __builtin_amdgcn_exp2f(x); }
__device__ __forceinline__ float rcpf(float x) { return __builtin_amdgcn_rcpf(x); }

namespace pg8 {
constexpr int BM = 256, BK = 64, HALF = 128, HTB = HALF * BK * 2, STAGE_BYTES = 8 * HTB, NXCD = 8, WGM = 8;
__host__ __device__ __forceinline__ int lds_byte(int r, int c) { const int st = (r >> 4) * 2 + (c >> 5), rr = r & 15, cc = c & 31, ob = rr * 64 + cc * 2; return st * 1024 + (ob ^ (((ob >> 9) & 1) << 5)); }
__host__ __device__ __forceinline__ void stage_rc(int b, int& R, int& C) { const int st = b / 1024, sb = b % 1024, swz = sb ^ (((sb >> 9) & 1) << 5); R = (st >> 1) * 16 + swz / 64; C = (st & 1) * 32 + (swz % 64) / 2; }
__host__ __device__ __forceinline__ int perm32(int rho) { const int n = rho >> 4, i = rho & 15; return 8 * (i >> 2) + 4 * n + (i & 3); }

struct Unit { int pm, pn, g; };
struct Gemm { const bf16_t* A; const bf16_t* Bt; int lda, ldb, K; size_t gsA, gsB; };

struct StaticOrder {
    int nM, nN, nwg, G, c;
    __device__ void init(int M, int N, int G_, int c_) { nM = M / BM; nN = N / BM; nwg = nM * nN; G = G_; c = c_; }
    __device__ bool next(int i, Unit& u) const {
        const long L = (long)i * G + c; if (L >= nwg) return false;
        int wgid = (int)L; { const int q = nwg / NXCD, r = nwg % NXCD, xcd = wgid % NXCD, off = wgid / NXCD; wgid = (xcd < r ? xcd * (q + 1) : r * (q + 1) + (xcd - r) * q) + off; }
        const int nig = WGM * nN, gid = wgid / nig, fm = gid * WGM, gsz = (nM - fm) < WGM ? (nM - fm) : WGM;
        u.pm = fm + ((wgid % nig) % gsz); u.pn = (wgid % nig) / gsz; u.g = 0; return true;
    }
    __device__ __forceinline__ void k_hook(int, int) const {}
};
struct BatchOrder {
    int G, c, total, npm, npn;
    __device__ bool next(int i, Unit& u) const {
        const int L = i * G + c; if (L >= total || c >= G) return false;
        const int per = npm * npn; u.g = L / per; const int r = L % per; u.pm = r / npn; u.pn = r % npn; return true;
    }
    __device__ __forceinline__ void k_hook(int, int) const {}
};
struct GatedBatchOrder : BatchOrder {
    unsigned* flag; unsigned epoch; static constexpr int tgate = 6;
    __device__ __forceinline__ void k_hook(int t, int wid) const {
        if (t == tgate) {
            if (wid == 0) {
                unsigned sp = 0;
                while ((unsigned)__builtin_amdgcn_readfirstlane(__hip_atomic_load(flag, __ATOMIC_RELAXED, __HIP_MEMORY_SCOPE_AGENT)) != epoch) { __builtin_amdgcn_s_sleep(2); if (++sp > (1u << 22)) break; }
                __builtin_amdgcn_fence(__ATOMIC_ACQUIRE, "agent");
                asm volatile("s_waitcnt vmcnt(0)" ::: "memory");
            }
            asm volatile("" ::: "memory"); __builtin_amdgcn_s_barrier(); asm volatile("" ::: "memory");
        }
    }
};

struct NoPre { __device__ __forceinline__ void operator()() const {} };
struct RsPre {
    const float* part; LAS float* rsl; int pm0, pm1; int ntab;
    __device__ __forceinline__ void operator()() const {
        const int tid = threadIdx.x;
        if (tid < 256 * ntab) { const f32x4* p = (const f32x4*)(part + ((size_t)((tid < 256 ? pm0 : pm1) * 256 + (tid & 255))) * 16); const f32x4 a = p[0], b = p[1], c = p[2], d = p[3];
            const float s = (((a.x + a.y) + (a.z + a.w)) + ((b.x + b.y) + (b.z + b.w))) + (((c.x + c.y) + (c.z + c.w)) + ((d.x + d.y) + (d.z + d.w))); rsl[tid] = __builtin_amdgcn_rsqf(s * (1.0f / 1024.0f) + 1e-6f); }
    }
};
template <class Epi, class Sched, bool ALIGN_EPI = true, bool SP2 = true, class Pre = NoPre>
__device__ __forceinline__ void gemm_phase(LAS unsigned char* lds, const Gemm g, const Sched& S, const Epi& E, const Pre& pre = Pre()) {
    int tid_ = threadIdx.x; asm volatile("" : "+v"(tid_));
    const int tid = tid_, wid = __builtin_amdgcn_readfirstlane(tid >> 6), lane = tid & 63, wr = wid >> 2, wc = wid & 3, fr = lane & 15, fq = lane >> 4;
    const int nt = g.K / BK;
    unsigned voffA[2], voffB[2];
#pragma unroll
    for (int i = 0; i < 2; ++i) { int R, C; stage_rc(tid * 16 + i * 8192, R, C); const int Rb = Epi::PERM ? ((R & ~31) + perm32(R & 31)) : R;
        voffA[i] = (unsigned)(R * g.lda + C) * 2u; voffB[i] = (unsigned)(Rb * g.ldb + C) * 2u; }
    const size_t kstep = (size_t)(BK * 2);
    const size_t hsA = (size_t)HALF * g.lda * 2, hsB = (size_t)HALF * g.ldb * 2;
    const unsigned ldsw = (unsigned)wid * 1024u;
    const int aoff = lds_byte(wr * 64 + fr, fq * 8), boff = lds_byte(wc * 32 + fr, fq * 8);
#define PG8_TILE_A(u) ((const char*)g.A + ((size_t)(u).g * g.gsA + (size_t)(u).pm * BM * g.lda) * 2)
#define PG8_TILE_B(u) ((const char*)g.Bt + ((size_t)(u).g * g.gsB + (size_t)(u).pn * BM * g.ldb) * 2)
#define PG8_SA(b, h) (((b) * 2 + (h)) * HTB)
#define PG8_SB(b, h) ((4 + (b) * 2 + (h)) * HTB)
#define PG8_STAGE(bufoff, gbase, voff) do { _Pragma("unroll") for (int _i = 0; _i < 2; ++_i) \
        __builtin_amdgcn_global_load_lds((const unsigned*)((const char*)(gbase) + (voff)[_i]), (LAS unsigned*)(lds + (bufoff) + ldsw + _i * 8192), 16, 0, 0); } while (0)
#define PG8_LDA(dst, b, h) do { _Pragma("unroll") for (int m = 0; m < 4; ++m) _Pragma("unroll") for (int k = 0; k < 2; ++k) dst[m][k] = *(const LAS bf16x8*)(lds + PG8_SA(b, h) + aoff + m * 2048 + k * 1024); } while (0)
#define PG8_LDB(dst, b, h) do { _Pragma("unroll") for (int n = 0; n < 2; ++n) _Pragma("unroll") for (int k = 0; k < 2; ++k) dst[n][k] = *(const LAS bf16x8*)(lds + PG8_SB(b, h) + boff + n * 2048 + k * 1024); } while (0)
#define PG8_MMA(ai, bj, At, Bt) do { __builtin_amdgcn_s_setprio(1); _Pragma("unroll") for (int m = 0; m < 4; ++m) _Pragma("unroll") for (int n = 0; n < 2; ++n) _Pragma("unroll") for (int k = 0; k < 2; ++k) \
        acc[ai][bj][m][n] = __builtin_amdgcn_mfma_f32_16x16x32_bf16(Bt[n][k], At[m][k], acc[ai][bj][m][n], 0, 0, 0); __builtin_amdgcn_s_setprio(0); } while (0)
#define PG8_WAIT_V(n) asm volatile("s_waitcnt vmcnt(" #n ")" ::: "memory")
#define PG8_WAIT_L(n) asm volatile("s_waitcnt lgkmcnt(" #n ")" ::: "memory")
#define PG8_BAR __builtin_amdgcn_s_barrier()
#define PG8_SCHED __builtin_amdgcn_sched_barrier(0)
    Unit cur, nxt; int ui = 0;
    if (!S.next(0, cur)) return;
    f32x4 acc[2][2][4][2];
#pragma unroll
    for (int a = 0; a < 2; ++a)
#pragma unroll
        for (int b = 0; b < 2; ++b)
#pragma unroll
            for (int m = 0; m < 4; ++m)
#pragma unroll
                for (int n = 0; n < 2; ++n) acc[a][b][m][n] = (f32x4){0.f, 0.f, 0.f, 0.f};
    bf16x8 At[4][2], B0[2][2], B1[2][2];
    const char* cA = PG8_TILE_A(cur); const char* cB = PG8_TILE_B(cur);
    if constexpr (SP2) {
        PG8_STAGE(PG8_SB(0, 0), cB, voffB); PG8_STAGE(PG8_SB(0, 1), cB + hsB, voffB); PG8_STAGE(PG8_SA(0, 0), cA, voffA); PG8_STAGE(PG8_SA(0, 1), cA + hsA, voffA);
        pre();
        if (wr == 1) PG8_BAR;
        PG8_WAIT_V(2); PG8_BAR;
        PG8_STAGE(PG8_SB(1, 0), cB + kstep, voffB); PG8_STAGE(PG8_SA(1, 0), cA + kstep, voffA); PG8_STAGE(PG8_SB(1, 1), cB + hsB + kstep, voffB);
        PG8_WAIT_V(6); PG8_BAR;
    } else {
        PG8_STAGE(PG8_SB(0, 0), cB, voffB); PG8_STAGE(PG8_SA(0, 0), cA, voffA); PG8_STAGE(PG8_SB(0, 1), cB + hsB, voffB); PG8_STAGE(PG8_SA(0, 1), cA + hsA, voffA);
        if (wr == 1) PG8_BAR;
        PG8_WAIT_V(4); PG8_BAR;
        PG8_STAGE(PG8_SB(1, 0), cB + kstep, voffB); PG8_STAGE(PG8_SA(1, 0), cA + kstep, voffA); PG8_STAGE(PG8_SB(1, 1), cB + hsB + kstep, voffB);
        PG8_WAIT_V(6); PG8_BAR;
    }
    for (;;) {
        const bool has_next = S.next(ui + 1, nxt);
        const char* nA = has_next ? PG8_TILE_A(nxt) : cA; const char* nB = has_next ? PG8_TILE_B(nxt) : cB;
        for (int t = 0; t < nt; t += 2) {
            S.k_hook(t, wid);
            const bool last = (t == nt - 2);
            const char* a1 = cA + (size_t)(t + 1) * kstep;
            const char* a2 = last ? nA : cA + (size_t)(t + 2) * kstep; const char* b2 = last ? nB : cB + (size_t)(t + 2) * kstep;
            const char* a3 = a2 + kstep; const char* b3 = b2 + kstep;
            if constexpr (SP2) {
            PG8_LDB(B0, 0, 0); PG8_LDB(B1, 0, 1); PG8_SCHED; PG8_LDA(At, 0, 0); PG8_STAGE(PG8_SA(1, 1), a1 + hsA, voffA);
            PG8_WAIT_V(8); PG8_WAIT_L(0); PG8_BAR; PG8_MMA(0, 0, At, B0); PG8_MMA(0, 1, At, B1); PG8_BAR; PG8_SCHED;
            PG8_LDA(At, 0, 1); PG8_STAGE(PG8_SB(0, 0), b2, voffB); PG8_STAGE(PG8_SB(0, 1), b2 + hsB, voffB); PG8_STAGE(PG8_SA(0, 0), a2, voffA);
            PG8_WAIT_V(8); PG8_WAIT_L(0); PG8_BAR; PG8_MMA(1, 0, At, B0); PG8_MMA(1, 1, At, B1); PG8_BAR; PG8_SCHED;
            PG8_LDB(B0, 1, 0); PG8_LDB(B1, 1, 1); PG8_SCHED; PG8_LDA(At, 1, 0); PG8_STAGE(PG8_SA(0, 1), a2 + hsA, voffA);
            PG8_WAIT_V(8); PG8_WAIT_L(0); PG8_BAR; PG8_MMA(0, 0, At, B0); PG8_MMA(0, 1, At, B1); PG8_BAR; PG8_SCHED;
            PG8_LDA(At, 1, 1); PG8_STAGE(PG8_SB(1, 0), b3, voffB); PG8_STAGE(PG8_SB(1, 1), b3 + hsB, voffB); PG8_STAGE(PG8_SA(1, 0), a3, voffA);
            PG8_WAIT_V(8); PG8_WAIT_L(0); PG8_BAR; PG8_MMA(1, 0, At, B0); PG8_MMA(1, 1, At, B1); PG8_BAR; PG8_SCHED;
            } else {
            PG8_LDB(B0, 0, 0); PG8_SCHED; PG8_LDA(At, 0, 0); PG8_STAGE(PG8_SA(1, 1), a1 + hsA, voffA);
            PG8_WAIT_L(8); PG8_BAR; PG8_WAIT_L(0); PG8_MMA(0, 0, At, B0); PG8_BAR; PG8_SCHED;
            PG8_LDB(B1, 0, 1); PG8_STAGE(PG8_SB(0, 0), b2, voffB);
            PG8_BAR; PG8_WAIT_L(0); PG8_MMA(0, 1, At, B1); PG8_BAR;
            PG8_LDA(At, 0, 1); PG8_STAGE(PG8_SA(0, 0), a2, voffA);
            PG8_BAR; PG8_WAIT_L(0); PG8_MMA(1, 0, At, B0); PG8_BAR; PG8_SCHED;
            PG8_STAGE(PG8_SB(0, 1), b2 + hsB, voffB);
            PG8_WAIT_V(6); PG8_BAR; PG8_MMA(1, 1, At, B1); PG8_BAR;
            PG8_LDB(B0, 1, 0); PG8_SCHED; PG8_LDA(At, 1, 0); PG8_STAGE(PG8_SA(0, 1), a2 + hsA, voffA);
            PG8_WAIT_L(8); PG8_BAR; PG8_WAIT_L(0); PG8_MMA(0, 0, At, B0); PG8_BAR; PG8_SCHED;
            PG8_LDB(B1, 1, 1); PG8_STAGE(PG8_SB(1, 0), b3, voffB);
            PG8_BAR; PG8_WAIT_L(0); PG8_MMA(0, 1, At, B1); PG8_BAR;
            PG8_LDA(At, 1, 1); PG8_STAGE(PG8_SA(1, 0), a3, voffA);
            PG8_BAR; PG8_WAIT_L(0); PG8_MMA(1, 0, At, B0); PG8_BAR; PG8_SCHED;
            PG8_STAGE(PG8_SB(1, 1), b3 + hsB, voffB);
            PG8_WAIT_V(6); PG8_BAR; PG8_MMA(1, 1, At, B1); PG8_BAR;
            }
        }
        if constexpr (ALIGN_EPI) { if (wr == 0) PG8_BAR; }
        E(acc, cur, wr, wc, fr, fq);
        if (!has_next) break;
#pragma unroll
        for (int a = 0; a < 2; ++a)
#pragma unroll
            for (int b = 0; b < 2; ++b)
#pragma unroll
                for (int m = 0; m < 4; ++m)
#pragma unroll
                    for (int n = 0; n < 2; ++n) acc[a][b][m][n] = (f32x4){0.f, 0.f, 0.f, 0.f};
        cur = nxt; cA = nA; cB = nB; ++ui;
        if constexpr (ALIGN_EPI) { if (wr == 1) PG8_BAR; }
    }
    PG8_WAIT_V(0);
    if constexpr (!ALIGN_EPI) { if (wr == 0) PG8_BAR; }
    PG8_BAR;
#undef PG8_TILE_A
#undef PG8_TILE_B
#undef PG8_SA
#undef PG8_SB
#undef PG8_STAGE
#undef PG8_LDA
#undef PG8_LDB
#undef PG8_MMA
#undef PG8_WAIT_V
#undef PG8_WAIT_L
#undef PG8_BAR
#undef PG8_SCHED
}
}
using pg8::Unit;

__device__ __forceinline__ float row_rs(const float* part, int row) {
    const f32x4* p = (const f32x4*)(part + (size_t)row * 16);
    const f32x4 a = p[0], b = p[1], c = p[2], d = p[3];
    const float s = (((a.x + a.y) + (a.z + a.w)) + ((b.x + b.y) + (b.z + b.w))) + (((c.x + c.y) + (c.z + c.w)) + ((d.x + d.y) + (d.z + d.w)));
    return __builtin_amdgcn_rsqf(s * (1.0f / 1024.0f) + EPS);
}
__device__ __forceinline__ u32x4 pack8(f32x4 v0, f32x4 v1) { u32x4 w; w.x = pk2(v0[0], v0[1]); w.y = pk2(v0[2], v0[3]); w.z = pk2(v1[0], v1[1]); w.w = pk2(v1[2], v1[3]); return w; }

struct EpiInProj {
    static constexpr bool PERM = true;
    const LAS float* rsl; int pm0; bf16_t *Q, *K, *V, *UB;
    __device__ __forceinline__ void operator()(const f32x4 (&acc)[2][2][4][2], const Unit& u, int wr, int wc, int fr, int fq) const {
        const int row0 = u.pm * 256 + wr * 64 + fr;
        const LAS float* rt = rsl + (u.pm == pm0 ? 0 : 256);
#pragma unroll
        for (int ai = 0; ai < 2; ++ai)
#pragma unroll
            for (int m = 0; m < 4; ++m) {
                const int row = row0 + ai * 128 + m * 16; const float rs = rt[ai * 128 + wr * 64 + m * 16 + fr];
#pragma unroll
                for (int bj = 0; bj < 2; ++bj) {
                    const int cb = bj * 128 + wc * 32 + 8 * fq;
                    const u32x4 w = pack8(acc[ai][bj][m][0] * rs, acc[ai][bj][m][1] * rs);
                    bf16_t* dst;
                    if (u.pn < 2) dst = Q + (size_t)row * 512 + u.pn * 256 + cb;
                    else if (u.pn == 2) dst = (bj == 0 ? K : V) + (size_t)row * 128 + wc * 32 + 8 * fq;
                    else { const int j = (u.pn - 3) * 256 + cb, g = j >> 4, h = j & 15; dst = UB + ((size_t)(g * NCH + (row >> 5)) * UK + (row & 31) * 16 + h); }
                    *(u32x4*)dst = w;
                }
            }
    }
};
struct EpiState {
    static constexpr bool PERM = false;
    float* S;
    __device__ __forceinline__ void operator()(const f32x4 (&acc)[2][2][4][2], const Unit& u, int wr, int wc, int fr, int fq) const {
        const int row0 = u.pm * 256 + wr * 64 + fr;
#pragma unroll
        for (int ai = 0; ai < 2; ++ai)
#pragma unroll
            for (int m = 0; m < 4; ++m) {
                float* rp = S + ((size_t)u.g * NCH + row0 + ai * 128 + m * 16) * 256 + wc * 32 + 4 * fq;
#pragma unroll
                for (int bj = 0; bj < 2; ++bj)
#pragma unroll
                    for (int n = 0; n < 2; ++n) *(f32x4*)(rp + bj * 128 + n * 16) = acc[ai][bj][m][n];
            }
    }
};
__device__ __forceinline__ float gelu_tanh(float x) {
    const float t = x + 0.044715f * x * x * x;
    return x * rcpf(1.0f + ex2(-1.5957691216057308f * LOG2E * t));
}
struct EpiSsmOut {
    static constexpr bool PERM = true;
    bf16_t* Y;
    __device__ __forceinline__ void operator()(const f32x4 (&acc)[2][2][4][2], const Unit& u, int wr, int wc, int fr, int fq) const {
        const int row0 = u.pm * 256 + wr * 64 + fr;
#pragma unroll
        for (int ai = 0; ai < 2; ++ai)
#pragma unroll
            for (int m = 0; m < 4; ++m) {
                const int chunk = row0 + ai * 128 + m * 16;
#pragma unroll
                for (int bj = 0; bj < 2; ++bj) {
                    const int c = u.pn * 256 + bj * 128 + wc * 32 + 8 * fq, t = c >> 4, h = c & 15;
                    f32x4 v0 = acc[ai][bj][m][0], v1 = acc[ai][bj][m][1];
#pragma unroll
                    for (int e = 0; e < 4; ++e) { v0[e] = gelu_tanh(v0[e]); v1[e] = gelu_tanh(v1[e]); }
                    *(u32x4*)(Y + (size_t)(chunk * CH + t) * 512 + u.g * 16 + h) = pack8(v0, v1);
                }
            }
    }
};
struct EpiGlu {
    static constexpr bool PERM = true;
    bf16_t* MIX;
    __device__ __forceinline__ void operator()(const f32x4 (&acc)[2][2][4][2], const Unit& u, int wr, int wc, int fr, int fq) const {
        const int row0 = u.pm * 256 + wr * 64 + fr;
#pragma unroll
        for (int ai = 0; ai < 2; ++ai)
#pragma unroll
            for (int m = 0; m < 4; ++m) {
                const int row = row0 + ai * 128 + m * 16;
#pragma unroll
                for (int bj = 0; bj < 2; ++bj) {
                    const int c = u.pn * 256 + bj * 128 + wc * 32 + 8 * fq;
                    const f32x4 v0 = acc[ai][bj][m][0], v1 = acc[ai][bj][m][1];
                    const float o0 = v0[0] * rcpf(1.0f + ex2(-LOG2E * v0[1])), o1 = v0[2] * rcpf(1.0f + ex2(-LOG2E * v0[3]));
                    const float o2 = v1[0] * rcpf(1.0f + ex2(-LOG2E * v1[1])), o3 = v1[2] * rcpf(1.0f + ex2(-LOG2E * v1[3]));
                    u32x2 w; w.x = pk2(o0, o1); w.y = pk2(o2, o3);
                    *(u32x2*)(MIX + (size_t)row * 1024 + 512 + (c >> 1)) = w;
                }
            }
    }
};
struct EpiRes {
    static constexpr bool PERM = true;
    const float* base32;
    float* out32;
    bf16_t* XN; float* part;
    __device__ __forceinline__ void operator()(const f32x4 (&acc)[2][2][4][2], const Unit& u, int wr, int wc, int fr, int fq) const {
        const int row0 = u.pm * 256 + wr * 64 + fr, col0 = u.pn * 256 + wc * 32 + 8 * fq;
        u32x4 bw[2][4][2];
        if (!base32) {
#pragma unroll
            for (int ai = 0; ai < 2; ++ai)
#pragma unroll
                for (int m = 0; m < 4; ++m)
#pragma unroll
                    for (int bj = 0; bj < 2; ++bj) bw[ai][m][bj] = *(const u32x4*)(XN + (size_t)(row0 + ai * 128 + m * 16) * DM + col0 + bj * 128);
        }
#pragma unroll
        for (int ai = 0; ai < 2; ++ai)
#pragma unroll
            for (int m = 0; m < 4; ++m) {
                const int row = row0 + ai * 128 + m * 16; const size_t off = (size_t)row * DM + col0; float ss = 0.f;
#pragma unroll
                for (int bj = 0; bj < 2; ++bj) {
                    f32x4 b0, b1;
                    if (base32) { b0 = __builtin_nontemporal_load((const f32x4*)(base32 + off + bj * 128)); b1 = __builtin_nontemporal_load((const f32x4*)(base32 + off + bj * 128 + 4)); }
                    else { const u32x4 w = bw[ai][m][bj]; b0 = (f32x4){bflo(w.x), bfhi(w.x), bflo(w.y), bfhi(w.y)}; b1 = (f32x4){bflo(w.z), bfhi(w.z), bflo(w.w), bfhi(w.w)}; }
                    const f32x4 x0 = b0 + acc[ai][bj][m][0], x1 = b1 + acc[ai][bj][m][1];
                    if (out32) { __builtin_nontemporal_store(x0, (f32x4*)(out32 + off + bj * 128)); __builtin_nontemporal_store(x1, (f32x4*)(out32 + off + bj * 128 + 4)); }
                    else *(u32x4*)(XN + off + bj * 128) = pack8(x0, x1);
                    ss += ((x0[0] * x0[0] + x0[1] * x0[1]) + (x0[2] * x0[2] + x0[3] * x0[3])) + ((x1[0] * x1[0] + x1[1] * x1[1]) + (x1[2] * x1[2] + x1[3] * x1[3]));
                }
                ss += __shfl_xor(ss, 16); ss += __shfl_xor(ss, 32);
                if (fq == 0) part[(size_t)row * 16 + u.pn * 4 + wc] = ss;
            }
    }
};
struct EpiFfn1 {
    static constexpr bool PERM = true;
    const LAS float* rsl; bf16_t* HID;
    __device__ __forceinline__ void operator()(const f32x4 (&acc)[2][2][4][2], const Unit& u, int wr, int wc, int fr, int fq) const {
        const int row0 = u.pm * 256 + wr * 64 + fr;
        const __amdgpu_buffer_rsrc_t hid = __builtin_amdgcn_make_buffer_rsrc(HID, 0, NTOK * FF * 2, 0x00020000);
#pragma unroll
        for (int ai = 0; ai < 2; ++ai)
#pragma unroll
            for (int m = 0; m < 4; ++m) {
                const int row = row0 + ai * 128 + m * 16; const float rs = rsl[ai * 128 + wr * 64 + m * 16 + fr];
#pragma unroll
                for (int bj = 0; bj < 2; ++bj) {
                    const int c = u.pn * 256 + bj * 128 + wc * 32 + 8 * fq;
                    f32x4 v0 = acc[ai][bj][m][0] * rs, v1 = acc[ai][bj][m][1] * rs;
#pragma unroll
                    for (int e = 0; e < 4; ++e) { const float a = fmaxf(v0[e], 0.f), b = fmaxf(v1[e], 0.f); v0[e] = a * a; v1[e] = b * b; }
                    __builtin_amdgcn_raw_buffer_store_b128(pack8(v0, v1), hid, (unsigned)(((size_t)row * FF + c) * 2), 0,   16);
                }
            }
    }
};

#define XB_TMO      128
#define XB_XCNT(j)  (256  + 64 * (j))
#define XB_XSUB(j)  (1280 + 64 * (j))
#define XB_XGEN(j)  (2304 + 64 * (j))
#define XB_TOP      3328
#define XB_TOPGEN   3392
#define XCD_BAR_WORDS 3456
#define XB_SPIN_CAP (1u << 22)
__device__ __forceinline__ unsigned xb_ld(unsigned* p)              { return __hip_atomic_load(p, __ATOMIC_RELAXED, __HIP_MEMORY_SCOPE_AGENT); }
__device__ __forceinline__ unsigned xb_add(unsigned* p, unsigned v) { return __hip_atomic_fetch_add(p, v, __ATOMIC_RELAXED, __HIP_MEMORY_SCOPE_AGENT); }
__device__ __forceinline__ unsigned xb_xcc_id() { return (unsigned)__builtin_amdgcn_s_getreg((3 << 11) | 20) & 0xFu; }
#define XB_SPIN(cond, bar) do { unsigned _sp = 0; while (cond) { __builtin_amdgcn_s_sleep(1); \
    if ((++_sp & 255u) == 0u) { if (xb_ld(&(bar)[XB_TMO])) break; if (_sp > XB_SPIN_CAP) { atomicAdd(&(bar)[XB_TMO], 1u); break; } } } } while (0)
struct XcdBarrier { unsigned* bar; unsigned x; volatile LAS unsigned* st; };
__device__ __forceinline__ XcdBarrier xcd_barrier_post(unsigned* bar, volatile LAS unsigned* st) {
    XcdBarrier b; b.bar = bar; b.x = xb_xcc_id(); b.st = st;
    if (threadIdx.x == 0) (void)xb_add(&bar[XB_XCNT(b.x)], 1u);
    return b;
}
__device__ __forceinline__ void xcd_barrier_complete(unsigned* bar, unsigned x, unsigned& nloc, unsigned& nx) {
    const unsigned G = gridDim.x * gridDim.y * gridDim.z;
    unsigned sum, cnt, mine, sp = 0u;
    for (;;) {
        sum = 0u; cnt = 0u; mine = 0u;
#pragma unroll
        for (unsigned j = 0; j < 16; ++j) { const unsigned c = xb_ld(&bar[XB_XCNT(j)]); sum += c; cnt += (c > 0u) ? 1u : 0u; mine = (j == x) ? c : mine; }
        if (sum == G) break;
        __builtin_amdgcn_s_sleep(1);
        if ((++sp & 255u) == 0u) { if (xb_ld(&bar[XB_TMO])) break; if (sp > XB_SPIN_CAP) { atomicAdd(&bar[XB_TMO], 1u); break; } }
    }
    nloc = mine > 0u ? mine : 1u; nx = cnt > 0u ? cnt : 1u;
}
__device__ __forceinline__ void xcd_barrier(const XcdBarrier& b) {
    asm volatile("s_waitcnt vmcnt(0)" ::: "memory");
    __syncthreads();
    if (threadIdx.x == 0) {
        unsigned* bar = b.bar;
        __builtin_amdgcn_s_waitcnt(0);
        unsigned nloc = b.st[0], nx = b.st[1];
        if (nloc == 0u) { xcd_barrier_complete(bar, b.x, nloc, nx); b.st[0] = nloc; b.st[1] = nx; }
        const unsigned old = xb_add(&bar[XB_XSUB(b.x)], 1u);
        const unsigned gen = old / nloc;
        if (old + 1u == (gen + 1u) * nloc) {
            __builtin_amdgcn_fence(__ATOMIC_RELEASE, "agent");
            asm volatile("s_waitcnt vmcnt(0)" ::: "memory");
            const unsigned og = xb_add(&bar[XB_TOP], 1u);
            const unsigned tg = og / nx;
            __builtin_amdgcn_fence(__ATOMIC_ACQUIRE, "agent");
            if (og + 1u == (tg + 1u) * nx) xb_add(&bar[XB_TOPGEN], 1u);
            else XB_SPIN(xb_ld(&bar[XB_TOPGEN]) == tg, bar);
            xb_add(&bar[XB_XGEN(b.x)], 1u);
            asm volatile("s_waitcnt vmcnt(0)" ::: "memory");
        } else {
            __builtin_amdgcn_fence(__ATOMIC_ACQUIRE, "agent");
            XB_SPIN(xb_ld(&bar[XB_XGEN(b.x)]) == gen, bar);
            asm volatile("s_waitcnt vmcnt(0)" ::: "memory");
        }
    }
    __syncthreads();
}

struct Args {
    const float *x, *norm1, *w_in, *q_gain, *k_gain, *sink, *lam_re, *lam_im, *log_dt, *b_re, *b_im, *c_re, *c_im, *d_skip, *w_glu, *w_out, *norm2, *w_ff1, *w_ff2;
    float* out; unsigned char* ws;
};

template <int MODE  >
__device__ __forceinline__ void p0_transpose_item(const float* W, int K, int N, const float* gain, bf16_t* WT, LAS float* scr, int item, int lane) {
    const int nblk = N / 64, kb = item / nblk, nb = item % nblk, k0 = 64 * kb, n0 = 64 * nb;
    const int lr = lane >> 4, lc = 4 * (lane & 15);
    f32x4 v[16];
#pragma unroll
    for (int i = 0; i < 16; ++i) v[i] = __builtin_nontemporal_load((const f32x4*)(W + (size_t)(k0 + 4 * i + lr) * N + n0 + lc));
#pragma unroll
    for (int i = 0; i < 16; ++i) { const int kk = 4 * i + lr; f32x4 x = v[i]; if (gain) x = x * gain[k0 + kk];
        LAS float* s = scr + kk * 65 + lc; s[0] = x[0]; s[1] = x[1]; s[2] = x[2]; s[3] = x[3]; }
    asm volatile("s_waitcnt lgkmcnt(0)" ::: "memory");
#pragma unroll
    for (int j = 0; j < 8; ++j) { const int piece = lane + 64 * j, n = piece >> 3, c = piece & 7; const LAS float* s = scr + (8 * c) * 65 + n;
        u32x4 o; o.x = pk2(s[0 * 65], s[1 * 65]); o.y = pk2(s[2 * 65], s[3 * 65]); o.z = pk2(s[4 * 65], s[5 * 65]); o.w = pk2(s[6 * 65], s[7 * 65]);
        const int nn = n0 + n; const int orow = (MODE == 1) ? (nn < 512 ? 2 * nn : 2 * (nn - 512) + 1) : nn;
        *(u32x4*)(WT + (size_t)orow * K + k0 + 8 * c) = o; }
    asm volatile("s_waitcnt lgkmcnt(0)" ::: "memory");
}

__device__ __forceinline__ f32x2 cmul(f32x2 a, f32x2 b) { return (f32x2){a.x * b.x - a.y * b.y, a.x * b.y + a.y * b.x}; }
__device__ __forceinline__ void ssm_gen(LAS unsigned char* lds, const Args& a, int layer, int g, int j8) {
    LAS f32x2* PW = (LAS f32x2*)lds;
    LAS f32x2* BB = PW + 2 * 33 * 64;
    LAS f32x2* CT = BB + 2 * 64 * 16;
    LAS float* KC = (LAS float*)(CT + 2 * 64 * 16);
    constexpr int KCS = 260;
    LAS float* DSK = KC + 2 * 32 * KCS;
    int tid_ = threadIdx.x; asm volatile("" : "+v"(tid_)); const int tid = tid_;
    bf16_t* MST = (bf16_t*)(a.ws + ((layer & 1) ? WS_MST2 : WS_MST)) + (size_t)g * 256 * 512;
    bf16_t* TOUT = (bf16_t*)(a.ws + ((layer & 1) ? WS_TOUT2 : WS_TOUT)) + (size_t)g * 512 * UK;
    f32x2* APOW = (f32x2*)(a.ws + WS_APOW) + (layer & 1) * 4096 + g * 128;
    if (tid < 16) DSK[tid] = a.d_skip[layer * 512 + g * 16 + tid];
    {
        const int p = tid & 63;
        float lrv[2], liv[2], dtv[2];
#pragma unroll
        for (int dir = 0; dir < 2; ++dir) { lrv[dir] = a.lam_re[((layer * 2 + dir) * 32 + g) * 64 + p]; liv[dir] = a.lam_im[((layer * 2 + dir) * 32 + g) * 64 + p]; dtv[dir] = __expf(a.log_dt[(layer * 2 + dir) * 32 + g]); }
#pragma unroll 1
        for (int r = 0; r < 9; ++r) {
            const int idx = tid + 512 * r;
            if (idx < 2 * 33 * 64) {
                const int dir = idx >= 33 * 64 ? 1 : 0, d = (idx - dir * 33 * 64) >> 6;
                const float lr = dir ? lrv[1] : lrv[0], li = dir ? liv[1] : liv[0], dt = dir ? dtv[1] : dtv[0];
                const float mag = __expf(lr * dt * (float)d);
                double rev = (double)li * (double)dt * 0.15915494309189535 * (double)d; rev -= __builtin_rint(rev);
                const float rv = (float)rev;
                PW[idx] = (f32x2){mag * __builtin_amdgcn_cosf(rv), mag * __builtin_amdgcn_sinf(rv)};
            }
        }
#pragma unroll
        for (int r = 0; r < 4; ++r) {
            const int i = tid + 512 * r, dir = i >> 10, pp = (i >> 4) & 63, h = i & 15;
            const float lr = a.lam_re[((layer * 2 + dir) * 32 + g) * 64 + pp], li = a.lam_im[((layer * 2 + dir) * 32 + g) * 64 + pp], dt = dir ? dtv[1] : dtv[0];
            const float mag = __expf(lr * dt);
            double rev = (double)li * (double)dt * 0.15915494309189535; rev -= __builtin_rint(rev);
            const float abx = mag * __builtin_amdgcn_cosf((float)rev), aby = mag * __builtin_amdgcn_sinf((float)rev);
            const float den = lr * lr + li * li;
            const float zr = ((abx - 1.0f) * lr + aby * li) / den, zi = (aby * lr - (abx - 1.0f) * li) / den;
            const float br = a.b_re[(((size_t)layer * 32 + g) * 64 + pp) * 16 + h], bi = a.b_im[(((size_t)layer * 32 + g) * 64 + pp) * 16 + h];
            BB[(dir * 64 + pp) * 16 + h] = (f32x2){zr * br - zi * bi, zr * bi + zi * br};
            const size_t ci = ((((size_t)layer * 2 + dir) * 32 + g) * 16 + h) * 64 + pp;
            CT[(dir * 64 + pp) * 16 + h] = (f32x2){a.c_re[ci], a.c_im[ci]};
        }
    }
    __syncthreads();
    if (j8 == 0 && tid < 128) APOW[tid] = PW[((tid >> 6) * 33 + 32) * 64 + (tid & 63)];
    const int ndf = 4 * j8 + 4;
    {
        const int wv = tid >> 6, l = tid & 63, col = l & 15, kq = l >> 4, part = kq & 1;
#pragma unroll 1
        for (int blk = wv; blk < 36; blk += 8) {
            const int dir = blk < ndf ? 0 : 1, d = dir ? blk - ndf : blk;
            f32x4 acc = {0.f, 0.f, 0.f, 0.f};
#pragma unroll 8
            for (int st = 0; st < 32; ++st) {
                const int p = 2 * st + (kq >> 1);
                const f32x2 c = CT[(dir * 64 + p) * 16 + col], w = PW[(dir * 33 + d) * 64 + p], bb = BB[(dir * 64 + p) * 16 + col];
                const float av = part ? -(c.x * w.y + c.y * w.x) : (c.x * w.x - c.y * w.y);
                const float bv = part ? bb.y : bb.x;
                acc = __builtin_amdgcn_mfma_f32_16x16x4f32(av, bv, acc, 0, 0, 0);
            }
#pragma unroll
            for (int i = 0; i < 4; ++i) KC[(dir * 32 + d) * KCS + (4 * kq + i) * 16 + col] = acc[i];
        }
    }
    __syncthreads();
#pragma unroll 1
    for (int r = 0; r < 12; ++r) {
        const int q = tid + 512 * r, n = 64 * j8 + q / 96, k0 = (q % 96) * 8, t = n >> 4, h = n & 15;
        float v[8];
        if (k0 < 512) {
            const int s = k0 >> 4, h0 = k0 & 15, d = t - s;
            if (d > 0) {
#pragma unroll
                for (int e = 0; e < 8; ++e) v[e] = KC[(0 * 32 + d) * KCS + h * 16 + h0 + e];
            } else if (d < 0) {
#pragma unroll
                for (int e = 0; e < 8; ++e) v[e] = KC[(1 * 32 - d) * KCS + h * 16 + h0 + e];
            } else {
                const float dd = DSK[h];
#pragma unroll
                for (int e = 0; e < 8; ++e) v[e] = KC[(0 * 32) * KCS + h * 16 + h0 + e] + KC[(1 * 32) * KCS + h * 16 + h0 + e] + ((h0 + e) == h ? dd : 0.f);
            }
        } else {
            const int kk = k0 - 512, dir = kk >> 7, reim = (kk >> 6) & 1, p0 = kk & 63, d = dir == 0 ? t + 1 : 32 - t;
#pragma unroll
            for (int e = 0; e < 8; ++e) { const f32x2 w = cmul(CT[(dir * 64 + p0 + e) * 16 + h], PW[(dir * 33 + d) * 64 + p0 + e]); v[e] = reim ? -w.y : w.x; }
        }
        u32x4 o; o.x = pk2(v[0], v[1]); o.y = pk2(v[2], v[3]); o.z = pk2(v[4], v[5]); o.w = pk2(v[6], v[7]);
        *(u32x4*)(TOUT + (size_t)n * UK + k0) = o;
    }
#pragma unroll 1
    for (int r = 0; r < 4; ++r) {
        const int q = tid + 512 * r, n = 32 * j8 + (q >> 6), k0 = (q & 63) * 8, s = k0 >> 4, h0 = k0 & 15, dir = n >> 7, reim = (n >> 6) & 1, p = n & 63, d = dir == 0 ? 31 - s : s;
        const f32x2 pw = PW[(dir * 33 + d) * 64 + p];
        float v[8];
#pragma unroll
        for (int e = 0; e < 8; ++e) { const f32x2 w = cmul(pw, BB[(dir * 64 + p) * 16 + h0 + e]); v[e] = reim ? w.y : w.x; }
        u32x4 o; o.x = pk2(v[0], v[1]); o.y = pk2(v[2], v[3]); o.z = pk2(v[4], v[5]); o.w = pk2(v[6], v[7]);
        *(u32x4*)(MST + (size_t)n * 512 + k0) = o;
    }
    __syncthreads();
}

__device__ __forceinline__ void carry_scan(LAS unsigned char* lds, const Args& a, int g, int b, int par) {
    int tid_ = threadIdx.x; asm volatile("" : "+v"(tid_)); const int tid = tid_;
    const int sp = tid & 127, seg = tid >> 7, dir = sp >> 6, p = sp & 63;
    const f32x2 aL = ((const f32x2*)(a.ws + WS_APOW))[par * 4096 + g * 128 + sp];
    f32x2 a64 = aL;
#pragma unroll
    for (int k = 0; k < 6; ++k) a64 = cmul(a64, a64);
    const float* S = (const float*)(a.ws + WS_S) + ((size_t)g * NCH + b * 256) * 256 + dir * 128 + p;
    bf16_t* U = (bf16_t*)(a.ws + WS_UB) + ((size_t)g * NCH + b * 256) * UK + 512 + dir * 128 + p;
    const int cbeg = dir ? 255 - seg * 64 : seg * 64, cstep = dir ? -1 : 1;
    float tr = 0.f, ti = 0.f;
#pragma unroll 1
    for (int i0 = 0; i0 < 64; i0 += 32) {
        float srv[32], siv[32];
#pragma unroll
        for (int k = 0; k < 32; ++k) { const int c = cbeg + cstep * (i0 + k); srv[k] = S[(size_t)c * 256]; siv[k] = S[(size_t)c * 256 + 64]; }
#pragma unroll
        for (int k = 0; k < 32; ++k) {
            const float nr = aL.x * tr - aL.y * ti + srv[k], ni = aL.x * ti + aL.y * tr + siv[k];
            tr = nr; ti = ni;
        }
    }
    LAS f32x2* TOT = (LAS f32x2*)lds;
    TOT[seg * 128 + sp] = (f32x2){tr, ti};
    __syncthreads();
    float cr = 0.f, ci = 0.f;
    for (int j = 0; j < seg; ++j) { const f32x2 t = TOT[j * 128 + sp]; const float nr = a64.x * cr - a64.y * ci + t.x, ni = a64.x * ci + a64.y * cr + t.y; cr = nr; ci = ni; }
#pragma unroll 1
    for (int i0 = 0; i0 < 64; i0 += 32) {
        float srv[32], siv[32];
#pragma unroll
        for (int k = 0; k < 32; ++k) { const int c = cbeg + cstep * (i0 + k); srv[k] = S[(size_t)c * 256]; siv[k] = S[(size_t)c * 256 + 64]; }
        asm volatile("" ::: "memory");
#pragma unroll
        for (int k = 0; k < 32; ++k) {
            const int c = cbeg + cstep * (i0 + k);
            U[(size_t)c * UK] = (bf16_t)(pk2(cr, 0.f) & 0xffffu); U[(size_t)c * UK + 64] = (bf16_t)(pk2(ci, 0.f) & 0xffffu);
            const float nr = aL.x * cr - aL.y * ci + srv[k], ni = aL.x * ci + aL.y * cr + siv[k];
            cr = nr; ci = ni;
        }
    }
    __syncthreads();
}

constexpr int KS_LD = 72, VT_LD = 388;
__device__ __forceinline__ int crow(int r, int hi) { return (r & 3) + 8 * (r >> 2) + 4 * hi; }
__device__ __forceinline__ void attn_unit(LAS unsigned char* lds, const Args& a, int layer, int b, int nb, int kh, float shift2) {
    int tid_ = threadIdx.x; asm volatile("" : "+v"(tid_)); const int tid = tid_, lane = tid & 63, wid = tid >> 6;
    LAS bf16_t* KS = (LAS bf16_t*)lds;
    LAS bf16_t* VT = (LAS bf16_t*)(lds + 384 * KS_LD * 2);
    const bf16_t* Qb = (const bf16_t*)(a.ws + WS_Q); const bf16_t* Kb = (const bf16_t*)(a.ws + WS_K); const bf16_t* Vb = (const bf16_t*)(a.ws + WS_V);
    bf16_t* MIX = (bf16_t*)(a.ws + WS_MIX);
    const float* qg = a.q_gain + layer * 64; const float* kg = a.k_gain + layer * 64;
    const int hq = kh * 4 + (wid >> 1), n = lane & 31, hi = lane >> 5;
    const int ib = (wid & 1) * 64;
    const size_t tok0 = (size_t)b * SEQ + nb * 128 + ib + n;
    const int part = tid & 7;
    u32x4 kraw[6], vraw[6], qraw[2][4];
#pragma unroll
    for (int r = 0; r < 6; ++r) {
        const int key = (tid >> 3) + 64 * r, pos = (nb - 1) * 128 + key;
        const size_t row = (size_t)b * SEQ + ((pos >= 0 && pos < SEQ) ? pos : 0);
        kraw[r] = *(const u32x4*)(Kb + row * 128 + kh * 64 + part * 8);
        vraw[r] = *(const u32x4*)(Vb + row * 128 + kh * 64 + part * 8);
    }
#pragma unroll
    for (int qt = 0; qt < 2; ++qt)
#pragma unroll
        for (int ks = 0; ks < 4; ++ks) qraw[qt][ks] = __builtin_nontemporal_load((const u32x4*)(Qb + (tok0 + 32 * qt) * 512 + hq * 64 + ks * 16 + hi * 8));
    const f32x4 kg0 = *(const f32x4*)(kg + part * 8), kg1 = *(const f32x4*)(kg + part * 8 + 4);
#pragma unroll
    for (int r = 0; r < 6; ++r) {
        const int key = (tid >> 3) + 64 * r;
        const u32x4 kr = kraw[r], vr = vraw[r];
        float kf[8] = {bflo(kr.x), bfhi(kr.x), bflo(kr.y), bfhi(kr.y), bflo(kr.z), bfhi(kr.z), bflo(kr.w), bfhi(kr.w)};
        float ss = 0.f;
#pragma unroll
        for (int e = 0; e < 8; ++e) ss += kf[e] * kf[e];
        ss += __shfl_xor(ss, 1); ss += __shfl_xor(ss, 2); ss += __shfl_xor(ss, 4);
        const float sc = __builtin_amdgcn_rsqf(ss * (1.0f / 64.0f) + EPS);
        u32x4 o; o.x = pk2(kf[0] * sc * kg0[0], kf[1] * sc * kg0[1]); o.y = pk2(kf[2] * sc * kg0[2], kf[3] * sc * kg0[3]);
        o.z = pk2(kf[4] * sc * kg1[0], kf[5] * sc * kg1[1]); o.w = pk2(kf[6] * sc * kg1[2], kf[7] * sc * kg1[3]);
        *(LAS u32x4*)(KS + key * KS_LD + part * 8) = o;
        LAS bf16_t* vp = VT + (part * 8) * VT_LD + key;
        vp[0 * VT_LD] = (bf16_t)(vr.x & 0xffffu); vp[1 * VT_LD] = (bf16_t)(vr.x >> 16);
        vp[2 * VT_LD] = (bf16_t)(vr.y & 0xffffu); vp[3 * VT_LD] = (bf16_t)(vr.y >> 16);
        vp[4 * VT_LD] = (bf16_t)(vr.z & 0xffffu); vp[5 * VT_LD] = (bf16_t)(vr.z >> 16);
        vp[6 * VT_LD] = (bf16_t)(vr.w & 0xffffu); vp[7 * VT_LD] = (bf16_t)(vr.w >> 16);
    }
    __syncthreads();
    const float slope2 = ex2(-(float)(hq + 1)) * LOG2E;
    const float sinkterm = ex2(a.sink[layer * 8 + hq] * LOG2E - shift2);
    bf16x8 qf[2][4];
#pragma unroll
    for (int qt = 0; qt < 2; ++qt) {
        u32x4 qr[4]; float ss = 0.f;
#pragma unroll
        for (int ks = 0; ks < 4; ++ks) { qr[ks] = qraw[qt][ks];
#pragma unroll
            for (int e = 0; e < 4; ++e) { const float lo = bflo(qr[ks][e]), hh = bfhi(qr[ks][e]); ss += lo * lo + hh * hh; } }
        ss += __shfl_xor(ss, 32);
        const float sc = __builtin_amdgcn_rsqf(ss * (1.0f / 64.0f) + EPS) * (0.125f * LOG2E);
#pragma unroll
        for (int ks = 0; ks < 4; ++ks) {
            const f32x4 g0 = *(const f32x4*)(qg + ks * 16 + hi * 8), g1 = *(const f32x4*)(qg + ks * 16 + hi * 8 + 4);
            u32x4 o; o.x = pk2(bflo(qr[ks].x) * sc * g0[0], bfhi(qr[ks].x) * sc * g0[1]); o.y = pk2(bflo(qr[ks].y) * sc * g0[2], bfhi(qr[ks].y) * sc * g0[3]);
            o.z = pk2(bflo(qr[ks].z) * sc * g1[0], bfhi(qr[ks].z) * sc * g1[1]); o.w = pk2(bflo(qr[ks].w) * sc * g1[2], bfhi(qr[ks].w) * sc * g1[3]);
            qf[qt][ks] = __builtin_bit_cast(bf16x8, o);
        }
    }
    f32x16 oa0, oa1, ob0, ob1; float la = 0.f, lb = 0.f;
#pragma unroll
    for (int e = 0; e < 16; ++e) { oa0[e] = 0.f; oa1[e] = 0.f; ob0[e] = 0.f; ob1[e] = 0.f; }
    const int kt0 = ib >> 5;
    const float nshift = -shift2;
#pragma unroll 1
    for (int kt = kt0; kt <= kt0 + 9; ++kt) {
        const int gb = nb - 1 + (kt >> 2);
        if (gb < 0 || gb >= SEQ / 128) continue;
        f32x16 sa, sb;
#pragma unroll
        for (int e = 0; e < 16; ++e) { sa[e] = nshift; sb[e] = nshift; }
#pragma unroll
        for (int ks = 0; ks < 4; ++ks) {
            const bf16x8 ka = *(const LAS bf16x8*)(KS + (32 * kt + n) * KS_LD + ks * 16 + hi * 8);
            sa = __builtin_amdgcn_mfma_f32_32x32x16_bf16(ka, qf[0][ks], sa, 0, 0, 0);
            sb = __builtin_amdgcn_mfma_f32_32x32x16_bf16(ka, qf[1][ks], sb, 0, 0, 0);
        }
        const float ea = (float)(32 * kt - (ib + n) - 128 + 4 * hi), eb = ea - 32.0f;
        if (kt <= kt0 + 1 || kt >= kt0 + 8) {
#pragma unroll
            for (int r = 0; r < 16; ++r) {
                const float da = __builtin_fabsf(ea + (float)crow(r, 0)), db = __builtin_fabsf(eb + (float)crow(r, 0));
                const float pa = da <= 128.0f ? ex2(sa[r] - slope2 * da) : 0.f, pb = db <= 128.0f ? ex2(sb[r] - slope2 * db) : 0.f;
                la += pa; lb += pb; sa[r] = pa; sb[r] = pb;
            }
        } else {
#pragma unroll
            for (int r = 0; r < 16; ++r) {
                const float pa = ex2(sa[r] - slope2 * __builtin_fabsf(ea + (float)crow(r, 0))), pb = ex2(sb[r] - slope2 * __builtin_fabsf(eb + (float)crow(r, 0)));
                la += pa; lb += pb; sa[r] = pa; sb[r] = pb;
            }
        }
        u32x4 pa0, pa1, pb0, pb1;
        pa0.x = pk2(sa[0], sa[1]); pa0.y = pk2(sa[2], sa[3]); pa0.z = pk2(sa[4], sa[5]); pa0.w = pk2(sa[6], sa[7]);
        pa1.x = pk2(sa[8], sa[9]); pa1.y = pk2(sa[10], sa[11]); pa1.z = pk2(sa[12], sa[13]); pa1.w = pk2(sa[14], sa[15]);
        pb0.x = pk2(sb[0], sb[1]); pb0.y = pk2(sb[2], sb[3]); pb0.z = pk2(sb[4], sb[5]); pb0.w = pk2(sb[6], sb[7]);
        pb1.x = pk2(sb[8], sb[9]); pb1.y = pk2(sb[10], sb[11]); pb1.z = pk2(sb[12], sb[13]); pb1.w = pk2(sb[14], sb[15]);
        const LAS bf16_t* vb = VT + n * VT_LD + 32 * kt + 4 * hi;
        {
            const s16x4 a0 = *(const LAS s16x4*)(vb), a1 = *(const LAS s16x4*)(vb + 8);
            const s16x4 c0 = *(const LAS s16x4*)(vb + 32 * VT_LD), c1 = *(const LAS s16x4*)(vb + 32 * VT_LD + 8);
            const bf16x8 v0 = __builtin_shufflevector(a0, a1, 0, 1, 2, 3, 4, 5, 6, 7), v1 = __builtin_shufflevector(c0, c1, 0, 1, 2, 3, 4, 5, 6, 7);
            oa0 = __builtin_amdgcn_mfma_f32_32x32x16_bf16(v0, __builtin_bit_cast(bf16x8, pa0), oa0, 0, 0, 0);
            oa1 = __builtin_amdgcn_mfma_f32_32x32x16_bf16(v1, __builtin_bit_cast(bf16x8, pa0), oa1, 0, 0, 0);
            ob0 = __builtin_amdgcn_mfma_f32_32x32x16_bf16(v0, __builtin_bit_cast(bf16x8, pb0), ob0, 0, 0, 0);
            ob1 = __builtin_amdgcn_mfma_f32_32x32x16_bf16(v1, __builtin_bit_cast(bf16x8, pb0), ob1, 0, 0, 0);
        }
        {
            const s16x4 a0 = *(const LAS s16x4*)(vb + 16), a1 = *(const LAS s16x4*)(vb + 24);
            const s16x4 c0 = *(const LAS s16x4*)(vb + 32 * VT_LD + 16), c1 = *(const LAS s16x4*)(vb + 32 * VT_LD + 24);
            const bf16x8 v0 = __builtin_shufflevector(a0, a1, 0, 1, 2, 3, 4, 5, 6, 7), v1 = __builtin_shufflevector(c0, c1, 0, 1, 2, 3, 4, 5, 6, 7);
            oa0 = __builtin_amdgcn_mfma_f32_32x32x16_bf16(v0, __builtin_bit_cast(bf16x8, pa1), oa0, 0, 0, 0);
            oa1 = __builtin_amdgcn_mfma_f32_32x32x16_bf16(v1, __builtin_bit_cast(bf16x8, pa1), oa1, 0, 0, 0);
            ob0 = __builtin_amdgcn_mfma_f32_32x32x16_bf16(v0, __builtin_bit_cast(bf16x8, pb1), ob0, 0, 0, 0);
            ob1 = __builtin_amdgcn_mfma_f32_32x32x16_bf16(v1, __builtin_bit_cast(bf16x8, pb1), ob1, 0, 0, 0);
        }
    }
    la += __shfl_xor(la, 32); lb += __shfl_xor(lb, 32);
    const float inva = 1.0f / (la + sinkterm), invb = 1.0f / (lb + sinkterm);
    bf16_t* opa = MIX + tok0 * 1024 + hq * 64 + 4 * hi; bf16_t* opb = opa + 32 * 1024;
#pragma unroll
    for (int j = 0; j < 4; ++j) {
        u32x2 w0, w1, w2, w3;
        w0.x = pk2(oa0[4 * j] * inva, oa0[4 * j + 1] * inva); w0.y = pk2(oa0[4 * j + 2] * inva, oa0[4 * j + 3] * inva);
        w1.x = pk2(oa1[4 * j] * inva, oa1[4 * j + 1] * inva); w1.y = pk2(oa1[4 * j + 2] * inva, oa1[4 * j + 3] * inva);
        w2.x = pk2(ob0[4 * j] * invb, ob0[4 * j + 1] * invb); w2.y = pk2(ob0[4 * j + 2] * invb, ob0[4 * j + 3] * invb);
        w3.x = pk2(ob1[4 * j] * invb, ob1[4 * j + 1] * invb); w3.y = pk2(ob1[4 * j + 2] * invb, ob1[4 * j + 3] * invb);
        *(u32x2*)(opa + 8 * j) = w0; *(u32x2*)(opa + 32 + 8 * j) = w1; *(u32x2*)(opb + 8 * j) = w2; *(u32x2*)(opb + 32 + 8 * j) = w3;
    }
    __syncthreads();
}

__global__ void __launch_bounds__(512, 2) mk_fwd(Args a) {
    extern __shared__ __attribute__((aligned(16))) unsigned char lds_raw[];
    LAS unsigned char* lds = (LAS unsigned char*)lds_raw;
    cg::grid_group grid = cg::this_grid();
    const int G = gridDim.x;
    if (threadIdx.x < 2) ((volatile LAS unsigned*)(lds + LDS_BARST))[threadIdx.x] = 0u;
    __syncthreads();
    if (a.ws == nullptr) grid.sync();
    const XcdBarrier xbar = xcd_barrier_post((unsigned*)(a.ws + WS_BAR), (volatile LAS unsigned*)(lds + LDS_BARST));

    {
        int tid_ = threadIdx.x, bx_ = blockIdx.x; asm volatile("" : "+v"(tid_)); asm volatile("" : "+s"(bx_));
        const int tid = tid_, lane = tid & 63, wave = tid >> 6, bx = bx_, layer = 0; (void)tid;
        unsigned char* ws = a.ws;
        bf16_t* WIN = (bf16_t*)(ws + WS_WIN); bf16_t* XN = (bf16_t*)(ws + WS_XN); float* PART = (float*)(ws + WS_PART);
        {
            if (bx >= 192) {
                ssm_gen(lds, a, layer, bx >> 3, bx & 7);
                LAS float* scr = (LAS float*)(lds + wave * 16640);
                constexpr int I_IN = (DM / 64) * (INW / 64);
                for (int it = (bx - 192) * 8 + wave; it < I_IN; it += 64 * 8) p0_transpose_item<0>(a.w_in + (size_t)layer * DM * INW, DM, INW, a.norm1 + layer * DM, WIN, scr, it, lane);
            } else {
                const int gw = bx * 8 + wave, NGW = 192 * 8;
                for (int m0 = gw * 4; m0 < NTOK; m0 += NGW * 4) {
                    f32x4 v[4][4];
#pragma unroll
                    for (int q = 0; q < 4; ++q)
#pragma unroll
                        for (int j = 0; j < 4; ++j) v[q][j] = __builtin_nontemporal_load((const f32x4*)(a.x + (size_t)(m0 + q) * DM) + lane + 64 * j);
#pragma unroll
                    for (int q = 0; q < 4; ++q) {
                        float ss = 0.f; unsigned long long* o8 = (unsigned long long*)(XN + (size_t)(m0 + q) * DM) + lane;
#pragma unroll
                        for (int j = 0; j < 4; ++j) { const f32x4 w = v[q][j]; ss += (w.x * w.x + w.y * w.y) + (w.z * w.z + w.w * w.w);
                            o8[64 * j] = (unsigned long long)pk2(w.x, w.y) | ((unsigned long long)pk2(w.z, w.w) << 32); }
#pragma unroll
                        for (int o = 1; o < 64; o <<= 1) ss += __shfl_xor(ss, o);
                        if (lane < 16) PART[(size_t)(m0 + q) * 16 + lane] = lane == 0 ? ss : 0.f;
                    }
                }
            }
        }
        GSYNC();
    }
#pragma unroll 1
    for (int layer = 0; layer < DEPTH; ++layer) {
        int tid_ = threadIdx.x, bx_ = blockIdx.x; asm volatile("" : "+v"(tid_)); asm volatile("" : "+s"(bx_));
        const int tid = tid_, lane = tid & 63, wave = tid >> 6, bx = bx_; (void)tid;
        const int par = layer & 1;
        unsigned char* ws = a.ws; asm volatile("" : "+s"(ws));
        bf16_t* WGLU = (bf16_t*)(ws + WS_WGLU); bf16_t* WOUT = (bf16_t*)(ws + WS_WOUT); bf16_t* W1 = (bf16_t*)(ws + WS_W1); bf16_t* W2 = (bf16_t*)(ws + WS_W2);
        bf16_t* XN = (bf16_t*)(ws + WS_XN); bf16_t* HID = (bf16_t*)(ws + WS_HID); bf16_t* MIX = (bf16_t*)(ws + WS_MIX); bf16_t* YB = (bf16_t*)(ws + WS_Y); bf16_t* UB = (bf16_t*)(ws + WS_UB);
        float* PART = (float*)(ws + WS_PART);
        bf16_t* WIN = (bf16_t*)(ws + (par ? WS_WIN2 : WS_WIN)); bf16_t* WINN = (bf16_t*)(ws + (par ? WS_WIN : WS_WIN2));
        for (int rp = 0; rp < REP_P1; ++rp) {
            pg8::Gemm g{XN, WIN, DM, DM, DM, 0, 0}; pg8::StaticOrder S; S.init(NTOK, INW, G, bx);
            LAS float* rsl = (LAS float*)(lds + 131072);
            Unit u0, u1; int pm0 = 0;
            pg8::RsPre pre{PART, rsl, 0, 0, 0};
            if (S.next(0, u0)) { pm0 = u0.pm; const bool two = S.next(1, u1); pre.pm0 = u0.pm; pre.pm1 = two ? u1.pm : u0.pm; pre.ntab = two ? 2 : 1; }
            EpiInProj E{rsl, pm0, (bf16_t*)(ws + WS_Q), (bf16_t*)(ws + WS_K), (bf16_t*)(ws + WS_V), UB};
            pg8::gemm_phase<EpiInProj, pg8::StaticOrder, true, true, pg8::RsPre>(lds, g, S, E, pre);
            if (bx >= 64 && rp == 0) {
                LAS float* scr = (LAS float*)(lds + wave * 16640);
                const int gw = (bx - 64) * 8 + wave, NGW = (G - 64) * 8;
                constexpr int I_GLU = (512 / 64) * (1024 / 64), I_OUT = (DM / 64) * (DM / 64), I_1 = (DM / 64) * (FF / 64), I_2 = (FF / 64) * (DM / 64);
                for (int it = gw; it < I_GLU + I_OUT + I_1 + I_2; it += NGW) {
                    int r = it;
                    if (r < I_GLU) { p0_transpose_item<1>(a.w_glu + (size_t)layer * 512 * 1024, 512, 1024, nullptr, WGLU, scr, r, lane); continue; } r -= I_GLU;
                    if (r < I_OUT) { p0_transpose_item<0>(a.w_out + (size_t)layer * DM * DM, DM, DM, nullptr, WOUT, scr, r, lane); continue; } r -= I_OUT;
                    if (r < I_1) { p0_transpose_item<0>(a.w_ff1 + (size_t)layer * DM * FF, DM, FF, a.norm2 + layer * DM, W1, scr, r, lane); continue; } r -= I_1;
                    p0_transpose_item<0>(a.w_ff2 + (size_t)layer * FF * DM, FF, DM, nullptr, W2, scr, r, lane);
                }
                if (layer + 1 < DEPTH) for (int it = gw; it < (DM / 64) * (INW / 64); it += NGW) p0_transpose_item<0>(a.w_in + (size_t)(layer + 1) * DM * INW, DM, INW, a.norm1 + (layer + 1) * DM, WINN, scr, it, lane);
                __syncthreads(); ssm_gen(lds, a, layer, (bx - 64) >> 3, (bx - 64) & 7);
            }
        }
        GSYNC();
        {
#define ATTN_SHIFT2(var) float var; { int ln_ = threadIdx.x & 63; asm volatile("" : "+v"(ln_)); float mq = fabsf(a.q_gain[layer * 64 + ln_]), mk = fabsf(a.k_gain[layer * 64 + ln_]); \
            _Pragma("unroll") for (int o = 1; o < 64; o <<= 1) { mq = fmaxf(mq, __shfl_xor(mq, o)); mk = fmaxf(mk, __shfl_xor(mk, o)); } var = 8.0f * mq * mk * LOG2E; }
            unsigned* flags = (unsigned*)(ws + WS_FLAG);
            const unsigned epoch = (unsigned)layer + 1u;
            if (bx < 64) {
                pg8::Gemm g{UB, (const bf16_t*)(ws + (par ? WS_MST2 : WS_MST)), UK, 512, 512, (size_t)NCH * UK, (size_t)256 * 512};
                const int cm = (bx & 7) * 8 + (bx >> 3);
                pg8::BatchOrder S{64, cm, 64, 2, 1};
                EpiState E{(float*)(ws + WS_S)};
                pg8::gemm_phase<EpiState, pg8::BatchOrder>(lds, g, S, E);
                asm volatile("s_waitcnt vmcnt(0)" ::: "memory"); __syncthreads();
                carry_scan(lds, a, cm >> 1, cm & 1, par);
                asm volatile("s_waitcnt vmcnt(0)" ::: "memory"); __syncthreads();
                if (tid == 0) { __builtin_amdgcn_fence(__ATOMIC_RELEASE, "agent"); asm volatile("s_waitcnt vmcnt(0)" ::: "memory"); __hip_atomic_store(flags + 64 * cm, epoch, __ATOMIC_RELAXED, __HIP_MEMORY_SCOPE_AGENT); }
                { const int u = 192 + (bx & 7) * 8 + (bx >> 3); ATTN_SHIFT2(shift2); attn_unit(lds, a, layer, u >> 7, (u >> 1) & 63, u & 1, shift2); }
            } else if (bx < 192) {
                const int v = bx - 64;
                { const int u = (v & 7) * 16 + (v >> 3); ATTN_SHIFT2(shift2); attn_unit(lds, a, layer, u >> 7, (u >> 1) & 63, u & 1, shift2); }
                const int cs = (v & 7) * 16 + (v >> 3);
                pg8::Gemm g{UB, (const bf16_t*)(ws + (par ? WS_TOUT2 : WS_TOUT)), UK, UK, UK, (size_t)NCH * UK, (size_t)512 * UK};
                pg8::GatedBatchOrder S; S.G = 128; S.c = cs; S.total = 128; S.npm = 2; S.npn = 2; S.flag = flags + 64 * ((cs >> 2) * 2 + ((cs >> 1) & 1)); S.epoch = epoch;
                EpiSsmOut E{YB};
                pg8::gemm_phase<EpiSsmOut, pg8::GatedBatchOrder>(lds, g, S, E);
            } else {
                { const int v = bx - 192, u = 128 + (v & 7) * 8 + (v >> 3); ATTN_SHIFT2(shift2); attn_unit(lds, a, layer, u >> 7, (u >> 1) & 63, u & 1, shift2); }
                if (layer + 1 < DEPTH) ssm_gen(lds, a, layer + 1, bx >> 3, bx & 7);
            }
        }
        GSYNC();
        for (int rp = 0; rp < REP_P5; ++rp) {
            pg8::Gemm g{YB, WGLU, 512, 512, 512, 0, 0}; pg8::StaticOrder S; S.init(NTOK, 1024, G, bx);
            EpiGlu E{MIX};
            pg8::gemm_phase<EpiGlu, pg8::StaticOrder>(lds, g, S, E);
        }
        GSYNC();
        {
            pg8::Gemm g{MIX, WOUT, DM, DM, DM, 0, 0}; pg8::StaticOrder S; S.init(NTOK, DM, G, bx);
            EpiRes E{layer == 0 ? a.x : nullptr, nullptr, XN, PART};
            pg8::gemm_phase<EpiRes, pg8::StaticOrder>(lds, g, S, E);
        }
        GSYNC();
        for (int rp = 0; rp < REP_P7; ++rp) {
            pg8::Gemm g{XN, W1, DM, DM, DM, 0, 0}; pg8::StaticOrder S; S.init(NTOK, FF, G, bx);
            LAS float* rsl = (LAS float*)(lds + 131072);
            pg8::RsPre pre{PART, rsl, 0, 0, 0};
            { Unit u0; if (S.next(0, u0)) { pre.pm0 = u0.pm; pre.ntab = 1; } }
            EpiFfn1 E{rsl, HID};
            pg8::gemm_phase<EpiFfn1, pg8::StaticOrder, true, true, pg8::RsPre>(lds, g, S, E, pre);
        }
        GSYNC();
        {
            pg8::Gemm g{HID, W2, FF, FF, FF, 0, 0}; pg8::StaticOrder S; S.init(NTOK, DM, G, bx);
            EpiRes E{nullptr, layer == DEPTH - 1 ? a.out : nullptr, XN, PART};
            pg8::gemm_phase<EpiRes, pg8::StaticOrder>(lds, g, S, E);
        }
        if (layer + 1 < DEPTH) GSYNC();
    }
}

extern "C" void kernel_launch(void* const* d_in, const int* in_sizes, int n_in, void* d_out, int out_size, void* d_ws, size_t ws_size, hipStream_t stream) {
    static int grid = 0;
    if (grid == 0) {
        if (n_in != 19 || in_sizes[0] != NTOK * DM || out_size != NTOK * DM || ws_size < WS_END) { fprintf(stderr, "kernel_launch: unexpected shapes (n_in %d, ws %zu)\n", n_in, ws_size); grid = -1; return; }
        int dev = 0, cus = 0, per_cu = 0;
        hipGetDevice(&dev); hipDeviceGetAttribute(&cus, hipDeviceAttributeMultiprocessorCount, dev);
        if (hipFuncSetAttribute((const void*)mk_fwd, hipFuncAttributeMaxDynamicSharedMemorySize, LDS_BYTES) != hipSuccess) { fprintf(stderr, "kernel_launch: hipFuncSetAttribute failed\n"); grid = -1; return; }
        if (hipOccupancyMaxActiveBlocksPerMultiprocessor(&per_cu, (const void*)mk_fwd, 512, LDS_BYTES) != hipSuccess || per_cu < 1) { fprintf(stderr, "kernel_launch: occupancy query gives %d\n", per_cu); per_cu = 1; }
        (void)hipGetLastError();
        if (cus < 256) { fprintf(stderr, "kernel_launch: built for a 256-CU device, found %d CUs\n", cus); grid = -1; return; }
        grid = 256;
    }
    if (grid < 0) return;
    if (hipMemsetAsync((char*)d_ws, 0, 131072, stream) != hipSuccess) { fprintf(stderr, "kernel_launch: memset failed\n"); return; }
    Args a{};
    const float** ap = (const float**)&a;
    for (int i = 0; i < 19; ++i) ap[i] = (const float*)d_in[i];
    a.out = (float*)d_out; a.ws = (unsigned char*)d_ws;
    void* args[] = {&a};
    hipError_t e = hipLaunchCooperativeKernel((const void*)mk_fwd, dim3(grid), dim3(512), args, LDS_BYTES, stream);
    if (e != hipSuccess) fprintf(stderr, "cooperative launch failed: %s (grid %d)\n", hipGetErrorString(e), grid);
}
```

```cpp
#include <hip/hip_runtime.h>
#include <hip/hip_cooperative_groups.h>
#include <cstdio>
#include <cstdint>
namespace cg = cooperative_groups;

#define LAS __attribute__((address_space(3)))
typedef unsigned short bf16_t;
typedef short bf16x8 __attribute__((ext_vector_type(8)));
typedef short s16x4 __attribute__((ext_vector_type(4)));
typedef float f32x4 __attribute__((ext_vector_type(4)));
typedef float f32x2 __attribute__((ext_vector_type(2)));
typedef float f32x16 __attribute__((ext_vector_type(16)));
typedef unsigned u32x4 __attribute__((ext_vector_type(4)));
typedef unsigned u32x2 __attribute__((ext_vector_type(2)));
typedef __bf16 bf2_t __attribute__((ext_vector_type(2)));

constexpr int NTOK = 16384, SEQ = 8192, DM = 1024, INW = 1280, FF = 4096, DEPTH = 4;
constexpr int CH = 32;
constexpr int NCH = NTOK / CH;
constexpr int UK = CH * 16 + 256;
constexpr float EPS = 1e-6f;
constexpr float LOG2E = 1.4426950408889634f;

constexpr size_t MiB = 1u << 20;
constexpr size_t WS_WIN = 1 * MiB;
constexpr size_t WS_WGLU = WS_WIN + 5 * MiB / 2;
constexpr size_t WS_WOUT = WS_WGLU + 1 * MiB;
constexpr size_t WS_W1 = WS_WOUT + 2 * MiB;
constexpr size_t WS_W2 = WS_W1 + 8 * MiB;
constexpr size_t WS_MST = 24 * MiB;
constexpr size_t WS_TOUT = 32 * MiB;
constexpr size_t WS_XN = 56 * MiB;
constexpr size_t WS_HID = 88 * MiB;
constexpr size_t WS_Q = 88 * MiB;
constexpr size_t WS_K = 104 * MiB;
constexpr size_t WS_V = 108 * MiB;
constexpr size_t WS_UB = 112 * MiB;
constexpr size_t WS_S = 136 * MiB;
constexpr size_t WS_Y = 152 * MiB;
constexpr size_t WS_MIX = 168 * MiB;
constexpr size_t WS_PART = 216 * MiB;
constexpr size_t WS_APOW = 218 * MiB;
constexpr size_t WS_TOUT2 = 220 * MiB;
constexpr size_t WS_MST2 = 244 * MiB;
constexpr size_t WS_WIN2 = 252 * MiB;
constexpr size_t WS_END = 255 * MiB;

constexpr int LDS_BYTES = 147456;
constexpr int REP_SYNC = 1, REP_P0 = 1, REP_P1 = 1, REP_P2 = 1, REP_P4 = 1, REP_P5 = 1, REP_P7 = 1, REP_P0A = 1, REP_P0B = 1, REP_P2A = 1, REP_P2B = 1;
#define GSYNC() do { for (int rs_ = 0; rs_ < REP_SYNC; ++rs_) xcd_barrier(xbar); } while (0)
constexpr size_t WS_FLAG = 32768;
constexpr size_t WS_BAR = 65536;
constexpr int LDS_BARST = LDS_BYTES - 64;

__device__ __forceinline__ unsigned pk2(float lo, float hi) { f32x2 v = {lo, hi}; bf2_t b = __builtin_convertvector(v, bf2_t); return __builtin_bit_cast(unsigned, b); }
__device__ __forceinline__ float bflo(unsigned w) { return __builtin_bit_cast(float, w << 16); }
__device__ __forceinline__ float bfhi(unsigned w) { return __builtin_bit_cast(float, w & 0xffff0000u); }
__device__ __forceinline__ float ex2(float x) { return __builtin_amdgcn_exp2f(x); }
__device__ __forceinline__ float rcpf(float x) { return __builtin_amdgcn_rcpf(x); }

namespace pg8 {
constexpr int BM = 256, BK = 64, HALF = 128, HTB = HALF * BK * 2, STAGE_BYTES = 8 * HTB, NXCD = 8, WGM = 8;
__host__ __device__ __forceinline__ int lds_byte(int r, int c) { const int st = (r >> 4) * 2 + (c >> 5), rr = r & 15, cc = c & 31, ob = rr * 64 + cc * 2; return st * 1024 + (ob ^ (((ob >> 9) & 1) << 5)); }
__host__ __device__ __forceinline__ void stage_rc(int b, int& R, int& C) { const int st = b / 1024, sb = b % 1024, swz = sb ^ (((sb >> 9) & 1) << 5); R = (st >> 1) * 16 + swz / 64; C = (st & 1) * 32 + (swz % 64) / 2; }
__host__ __device__ __forceinline__ int perm32(int rho) { const int n = rho >> 4, i = rho & 15; return 8 * (i >> 2) + 4 * n + (i & 3); }

struct Unit { int pm, pn, g; };
struct Gemm { const bf16_t* A; const bf16_t* Bt; int lda, ldb, K; size_t gsA, gsB; };

struct StaticOrder {
    int nM, nN, nwg, G, c;
    __device__ void init(int M, int N, int G_, int c_) { nM = M / BM; nN = N / BM; nwg = nM * nN; G = G_; c = c_; }
    __device__ bool next(int i, Unit& u) const {
        const long L = (long)i * G + c; if (L >= nwg) return false;
        int wgid = (int)L; { const int q = nwg / NXCD, r = nwg % NXCD, xcd = wgid % NXCD, off = wgid / NXCD; wgid = (xcd < r ? xcd * (q + 1) : r * (q + 1) + (xcd - r) * q) + off; }
        const int nig = WGM * nN, gid = wgid / nig, fm = gid * WGM, gsz = (nM - fm) < WGM ? (nM - fm) : WGM;
        u.pm = fm + ((wgid % nig) % gsz); u.pn = (wgid % nig) / gsz; u.g = 0; return true;
    }
    __device__ __forceinline__ void k_hook(int, int) const {}
};
struct BatchOrder {
    int G, c, total, npm, npn;
    __device__ bool next(int i, Unit& u) const {
        const int L = i * G + c; if (L >= total || c >= G) return false;
        const int per = npm * npn; u.g = L / per; const int r = L % per; u.pm = r / npn; u.pn = r % npn; return true;
    }
    __device__ __forceinline__ void k_hook(int, int) const {}
};
struct GatedBatchOrder : BatchOrder {
    unsigned* flag; unsigned epoch; static constexpr int tgate = 6;
    __device__ __forceinline__ void k_hook(int t, int wid) const {
        if (t == tgate) {
            if (wid == 0) {
                unsigned sp = 0;
                while ((unsigned)__builtin_amdgcn_readfirstlane(__hip_atomic_load(flag, __ATOMIC_RELAXED, __HIP_MEMORY_SCOPE_AGENT)) != epoch) { __builtin_amdgcn_s_sleep(2); if (++sp > (1u << 22)) break; }
                __builtin_amdgcn_fence(__ATOMIC_ACQUIRE, "agent");
                asm volatile("s_waitcnt vmcnt(0)" ::: "memory");
            }
            asm volatile("" ::: "memory"); __builtin_amdgcn_s_barrier(); asm volatile("" ::: "memory");
        }
    }
};

struct NoPre { __device__ __forceinline__ void operator()() const {} };
struct RsPre {
    const float* part; LAS float* rsl; int pm0, pm1; int ntab;
    __device__ __forceinline__ void operator()() const {
        const int tid = threadIdx.x;
        if (tid < 256 * ntab) { const f32x4* p = (const f32x4*)(part + ((size_t)((tid < 256 ? pm0 : pm1) * 256 + (tid & 255))) * 16); const f32x4 a = p[0], b = p[1], c = p[2], d = p[3];
            const float s = (((a.x + a.y) + (a.z + a.w)) + ((b.x + b.y) + (b.z + b.w))) + (((c.x + c.y) + (c.z + c.w)) + ((d.x + d.y) + (d.z + d.w))); rsl[tid] = __builtin_amdgcn_rsqf(s * (1.0f / 1024.0f) + 1e-6f); }
    }
};
template <class Epi, class Sched, bool ALIGN_EPI = true, bool SP2 = true, class Pre = NoPre>
__device__ __forceinline__ void gemm_phase(LAS unsigned char* lds, const Gemm g, const Sched& S, const Epi& E, const Pre& pre = Pre()) {
    int tid_ = threadIdx.x; asm volatile("" : "+v"(tid_));
    const int tid = tid_, wid = __builtin_amdgcn_readfirstlane(tid >> 6), lane = tid & 63, wr = wid >> 2, wc = wid & 3, fr = lane & 15, fq = lane >> 4;
    const int nt = g.K / BK;
    unsigned voffA[2], voffB[2];
#pragma unroll
    for (int i = 0; i < 2; ++i) { int R, C; stage_rc(tid * 16 + i * 8192, R, C); const int Rb = Epi::PERM ? ((R & ~31) + perm32(R & 31)) : R;
        voffA[i] = (unsigned)(R * g.lda + C) * 2u; voffB[i] = (unsigned)(Rb * g.ldb + C) * 2u; }
    const size_t kstep = (size_t)(BK * 2);
    const size_t hsA = (size_t)HALF * g.lda * 2, hsB = (size_t)HALF * g.ldb * 2;
    const unsigned ldsw = (unsigned)wid * 1024u;
    const int aoff = lds_byte(wr * 64 + fr, fq * 8), boff = lds_byte(wc * 32 + fr, fq * 8);
#define PG8_TILE_A(u) ((const char*)g.A + ((size_t)(u).g * g.gsA + (size_t)(u).pm * BM * g.lda) * 2)
#define PG8_TILE_B(u) ((const char*)g.Bt + ((size_t)(u).g * g.gsB + (size_t)(u).pn * BM * g.ldb) * 2)
#define PG8_SA(b, h) (((b) * 2 + (h)) * HTB)
#define PG8_SB(b, h) ((4 + (b) * 2 + (h)) * HTB)
#define PG8_STAGE(bufoff, gbase, voff) do { _Pragma("unroll") for (int _i = 0; _i < 2; ++_i) \
        __builtin_amdgcn_global_load_lds((const unsigned*)((const char*)(gbase) + (voff)[_i]), (LAS unsigned*)(lds + (bufoff) + ldsw + _i * 8192), 16, 0, 0); } while (0)
#define PG8_LDA(dst, b, h) do { _Pragma("unroll") for (int m = 0; m < 4; ++m) _Pragma("unroll") for (int k = 0; k < 2; ++k) dst[m][k] = *(const LAS bf16x8*)(lds + PG8_SA(b, h) + aoff + m * 2048 + k * 1024); } while (0)
#define PG8_LDB(dst, b, h) do { _Pragma("unroll") for (int n = 0; n < 2; ++n) _Pragma("unroll") for (int k = 0; k < 2; ++k) dst[n][k] = *(const LAS bf16x8*)(lds + PG8_SB(b, h) + boff + n * 2048 + k * 1024); } while (0)
#define PG8_MMA(ai, bj, At, Bt) do { __builtin_amdgcn_s_setprio(1); _Pragma("unroll") for (int m = 0; m < 4; ++m) _Pragma("unroll") for (int n = 0; n < 2; ++n) _Pragma("unroll") for (int k = 0; k < 2; ++k) \
        acc[ai][bj][m][n] = __builtin_amdgcn_mfma_f32_16x16x32_bf16(Bt[n][k], At[m][k], acc[ai][bj][m][n], 0, 0, 0); __builtin_amdgcn_s_setprio(0); } while (0)
#define PG8_WAIT_V(n) asm volatile("s_waitcnt vmcnt(" #n ")" ::: "memory")
#define PG8_WAIT_L(n) asm volatile("s_waitcnt lgkmcnt(" #n ")" ::: "memory")
#define PG8_BAR __builtin_amdgcn_s_barrier()
#define PG8_SCHED __builtin_amdgcn_sched_barrier(0)
    Unit cur, nxt; int ui = 0;
    if (!S.next(0, cur)) return;
    f32x4 acc[2][2][4][2];
#pragma unroll
    for (int a = 0; a < 2; ++a)
#pragma unroll
        for (int b = 0; b < 2; ++b)
#pragma unroll
            for (int m = 0; m < 4; ++m)
#pragma unroll
                for (int n = 0; n < 2; ++n) acc[a][b][m][n] = (f32x4){0.f, 0.f, 0.f, 0.f};
    bf16x8 At[4][2], B0[2][2], B1[2][2];
    const char* cA = PG8_TILE_A(cur); const char* cB = PG8_TILE_B(cur);
    if constexpr (SP2) {
        PG8_STAGE(PG8_SB(0, 0), cB, voffB); PG8_STAGE(PG8_SB(0, 1), cB + hsB, voffB); PG8_STAGE(PG8_SA(0, 0), cA, voffA); PG8_STAGE(PG8_SA(0, 1), cA + hsA, voffA);
        pre();
        if (wr == 1) PG8_BAR;
        PG8_WAIT_V(2); PG8_BAR;
        PG8_STAGE(PG8_SB(1, 0), cB + kstep, voffB); PG8_STAGE(PG8_SA(1, 0), cA + kstep, voffA); PG8_STAGE(PG8_SB(1, 1), cB + hsB + kstep, voffB);
        PG8_WAIT_V(6); PG8_BAR;
    } else {
        PG8_STAGE(PG8_SB(0, 0), cB, voffB); PG8_STAGE(PG8_SA(0, 0), cA, voffA); PG8_STAGE(PG8_SB(0, 1), cB + hsB, voffB); PG8_STAGE(PG8_SA(0, 1), cA + hsA, voffA);
        if (wr == 1) PG8_BAR;
        PG8_WAIT_V(4); PG8_BAR;
        PG8_STAGE(PG8_SB(1, 0), cB + kstep, voffB); PG8_STAGE(PG8_SA(1, 0), cA + kstep, voffA); PG8_STAGE(PG8_SB(1, 1), cB + hsB + kstep, voffB);
        PG8_WAIT_V(6); PG8_BAR;
    }
    for (;;) {
        const bool has_next = S.next(ui + 1, nxt);
        const char* nA = has_next ? PG8_TILE_A(nxt) : cA; const char* nB = has_next ? PG8_TILE_B(nxt) : cB;
        for (int t = 0; t < nt; t += 2) {
            S.k_hook(t, wid);
            const bool last = (t == nt - 2);
            const char* a1 = cA + (size_t)(t + 1) * kstep;
            const char* a2 = last ? nA : cA + (size_t)(t + 2) * kstep; const char* b2 = last ? nB : cB + (size_t)(t + 2) * kstep;
            const char* a3 = a2 + kstep; const char* b3 = b2 + kstep;
            if constexpr (SP2) {
            PG8_LDB(B0, 0, 0); PG8_LDB(B1, 0, 1); PG8_SCHED; PG8_LDA(At, 0, 0); PG8_STAGE(PG8_SA(1, 1), a1 + hsA, voffA);
            PG8_WAIT_V(8); PG8_WAIT_L(0); PG8_BAR; PG8_MMA(0, 0, At, B0); PG8_MMA(0, 1, At, B1); PG8_BAR; PG8_SCHED;
            PG8_LDA(At, 0, 1); PG8_STAGE(PG8_SB(0, 0), b2, voffB); PG8_STAGE(PG8_SB(0, 1), b2 + hsB, voffB); PG8_STAGE(PG8_SA(0, 0), a2, voffA);
            PG8_WAIT_V(8); PG8_WAIT_L(0); PG8_BAR; PG8_MMA(1, 0, At, B0); PG8_MMA(1, 1, At, B1); PG8_BAR; PG8_SCHED;
            PG8_LDB(B0, 1, 0); PG8_LDB(B1, 1, 1); PG8_SCHED; PG8_LDA(At, 1, 0); PG8_STAGE(PG8_SA(0, 1), a2 + hsA, voffA);
            PG8_WAIT_V(8); PG8_WAIT_L(0); PG8_BAR; PG8_MMA(0, 0, At, B0); PG8_MMA(0, 1, At, B1); PG8_BAR; PG8_SCHED;
            PG8_LDA(At, 1, 1); PG8_STAGE(PG8_SB(1, 0), b3, voffB); PG8_STAGE(PG8_SB(1, 1), b3 + hsB, voffB); PG8_STAGE(PG8_SA(1, 0), a3, voffA);
            PG8_WAIT_V(8); PG8_WAIT_L(0); PG8_BAR; PG8_MMA(1, 0, At, B0); PG8_MMA(1, 1, At, B1); PG8_BAR; PG8_SCHED;
            } else {
            PG8_LDB(B0, 0, 0); PG8_SCHED; PG8_LDA(At, 0, 0); PG8_STAGE(PG8_SA(1, 1), a1 + hsA, voffA);
            PG8_WAIT_L(8); PG8_BAR; PG8_WAIT_L(0); PG8_MMA(0, 0, At, B0); PG8_BAR; PG8_SCHED;
            PG8_LDB(B1, 0, 1); PG8_STAGE(PG8_SB(0, 0), b2, voffB);
            PG8_BAR; PG8_WAIT_L(0); PG8_MMA(0, 1, At, B1); PG8_BAR;
            PG8_LDA(At, 0, 1); PG8_STAGE(PG8_SA(0, 0), a2, voffA);
            PG8_BAR; PG8_WAIT_L(0); PG8_MMA(1, 0, At, B0); PG8_BAR; PG8_SCHED;
            PG8_STAGE(PG8_SB(0, 1), b2 + hsB, voffB);
            PG8_WAIT_V(6); PG8_BAR; PG8_MMA(1, 1, At, B1); PG8_BAR;
            PG8_LDB(B0, 1, 0); PG8_SCHED; PG8_LDA(At, 1, 0); PG8_STAGE(PG8_SA(0, 1), a2 + hsA, voffA);
            PG8_WAIT_L(8); PG8_BAR; PG8_WAIT_L(0); PG8_MMA(0, 0, At, B0); PG8_BAR; PG8_SCHED;
            PG8_LDB(B1, 1, 1); PG8_STAGE(PG8_SB(1, 0), b3, voffB);
            PG8_BAR; PG8_WAIT_L(0); PG8_MMA(0, 1, At, B1); PG8_BAR;
            PG8_LDA(At, 1, 1); PG8_STAGE(PG8_SA(1, 0), a3, voffA);
            PG8_BAR; PG8_WAIT_L(0); PG8_MMA(1, 0, At, B0); PG8_BAR; PG8_SCHED;
            PG8_STAGE(PG8_SB(1, 1), b3 + hsB, voffB);
            PG8_WAIT_V(6); PG8_BAR; PG8_MMA(1, 1, At, B1); PG8_BAR;
            }
        }
        if constexpr (ALIGN_EPI) { if (wr == 0) PG8_BAR; }
        E(acc, cur, wr, wc, fr, fq);
        if (!has_next) break;
#pragma unroll
        for (int a = 0; a < 2; ++a)
#pragma unroll
            for (int b = 0; b < 2; ++b)
#pragma unroll
                for (int m = 0; m < 4; ++m)
#pragma unroll
                    for (int n = 0; n < 2; ++n) acc[a][b][m][n] = (f32x4){0.f, 0.f, 0.f, 0.f};
        cur = nxt; cA = nA; cB = nB; ++ui;
        if constexpr (ALIGN_EPI) { if (wr == 1) PG8_BAR; }
    }
    PG8_WAIT_V(0);
    if constexpr (!ALIGN_EPI) { if (wr == 0) PG8_BAR; }
    PG8_BAR;
#undef PG8_TILE_A
#undef PG8_TILE_B
#undef PG8_SA
#undef PG8_SB
#undef PG8_STAGE
#undef PG8_LDA
#undef PG8_LDB
#undef PG8_MMA
#undef PG8_WAIT_V
#undef PG8_WAIT_L
#undef PG8_BAR
#undef PG8_SCHED
}
}
using pg8::Unit;

__device__ __forceinline__ float row_rs(const float* part, int row) {
    const f32x4* p = (const f32x4*)(part + (size_t)row * 16);
    const f32x4 a = p[0], b = p[1], c = p[2], d = p[3];
    const float s = (((a.x + a.y) + (a.z + a.w)) + ((b.x + b.y) + (b.z + b.w))) + (((c.x + c.y) + (c.z + c.w)) + ((d.x + d.y) + (d.z + d.w)));
    return __builtin_amdgcn_rsqf(s * (1.0f / 1024.0f) + EPS);
}
__device__ __forceinline__ u32x4 pack8(f32x4 v0, f32x4 v1) { u32x4 w; w.x = pk2(v0[0], v0[1]); w.y = pk2(v0[2], v0[3]); w.z = pk2(v1[0], v1[1]); w.w = pk2(v1[2], v1[3]); return w; }

struct EpiInProj {
    static constexpr bool PERM = true;
    const LAS float* rsl; int pm0; bf16_t *Q, *K, *V, *UB;
    __device__ __forceinline__ void operator()(const f32x4 (&acc)[2][2][4][2], const Unit& u, int wr, int wc, int fr, int fq) const {
        const int row0 = u.pm * 256 + wr * 64 + fr;
        const LAS float* rt = rsl + (u.pm == pm0 ? 0 : 256);
#pragma unroll
        for (int ai = 0; ai < 2; ++ai)
#pragma unroll
            for (int m = 0; m < 4; ++m) {
                const int row = row0 + ai * 128 + m * 16; const float rs = rt[ai * 128 + wr * 64 + m * 16 + fr];
#pragma unroll
                for (int bj = 0; bj < 2; ++bj) {
                    const int cb = bj * 128 + wc * 32 + 8 * fq;
                    const u32x4 w = pack8(acc[ai][bj][m][0] * rs, acc[ai][bj][m][1] * rs);
                    bf16_t* dst;
                    if (u.pn < 2) dst = Q + (size_t)row * 512 + u.pn * 256 + cb;
                    else if (u.pn == 2) dst = (bj == 0 ? K : V) + (size_t)row * 128 + wc * 32 + 8 * fq;
                    else { const int j = (u.pn - 3) * 256 + cb, g = j >> 4, h = j & 15; dst = UB + ((size_t)(g * NCH + (row >> 5)) * UK + (row & 31) * 16 + h); }
                    *(u32x4*)dst = w;
                }
            }
    }
};
struct EpiState {
    static constexpr bool PERM = false;
    float* S;
    __device__ __forceinline__ void operator()(const f32x4 (&acc)[2][2][4][2], const Unit& u, int wr, int wc, int fr, int fq) const {
        const int row0 = u.pm * 256 + wr * 64 + fr;
#pragma unroll
        for (int ai = 0; ai < 2; ++ai)
#pragma unroll
            for (int m = 0; m < 4; ++m) {
                float* rp = S + ((size_t)u.g * NCH + row0 + ai * 128 + m * 16) * 256 + wc * 32 + 4 * fq;
#pragma unroll
                for (int bj = 0; bj < 2; ++bj)
#pragma unroll
                    for (int n = 0; n < 2; ++n) *(f32x4*)(rp + bj * 128 + n * 16) = acc[ai][bj][m][n];
            }
    }
};
__device__ __forceinline__ float gelu_tanh(float x) {
    const float t = x + 0.044715f * x * x * x;
    return x * rcpf(1.0f + ex2(-1.5957691216057308f * LOG2E * t));
}
struct EpiSsmOut {
    static constexpr bool PERM = true;
    bf16_t* Y;
    __device__ __forceinline__ void operator()(const f32x4 (&acc)[2][2][4][2], const Unit& u, int wr, int wc, int fr, int fq) const {
        const int row0 = u.pm * 256 + wr * 64 + fr;
#pragma unroll
        for (int ai = 0; ai < 2; ++ai)
#pragma unroll
            for (int m = 0; m < 4; ++m) {
                const int chunk = row0 + ai * 128 + m * 16;
#pragma unroll
                for (int bj = 0; bj < 2; ++bj) {
                    const int c = u.pn * 256 + bj * 128 + wc * 32 + 8 * fq, t = c >> 4, h = c & 15;
                    f32x4 v0 = acc[ai][bj][m][0], v1 = acc[ai][bj][m][1];
#pragma unroll
                    for (int e = 0; e < 4; ++e) { v0[e] = gelu_tanh(v0[e]); v1[e] = gelu_tanh(v1[e]); }
                    *(u32x4*)(Y + (size_t)(chunk * CH + t) * 512 + u.g * 16 + h) = pack8(v0, v1);
                }
            }
    }
};
struct EpiGlu {
    static constexpr bool PERM = true;
    bf16_t* MIX;
    __device__ __forceinline__ void operator()(const f32x4 (&acc)[2][2][4][2], const Unit& u, int wr, int wc, int fr, int fq) const {
        const int row0 = u.pm * 256 + wr * 64 + fr;
#pragma unroll
        for (int ai = 0; ai < 2; ++ai)
#pragma unroll
            for (int m = 0; m < 4; ++m) {
                const int row = row0 + ai * 128 + m * 16;
#pragma unroll
                for (int bj = 0; bj < 2; ++bj) {
                    const int c = u.pn * 256 + bj * 128 + wc * 32 + 8 * fq;
                    const f32x4 v0 = acc[ai][bj][m][0], v1 = acc[ai][bj][m][1];
                    const float o0 = v0[0] * rcpf(1.0f + ex2(-LOG2E * v0[1])), o1 = v0[2] * rcpf(1.0f + ex2(-LOG2E * v0[3]));
                    const float o2 = v1[0] * rcpf(1.0f + ex2(-LOG2E * v1[1])), o3 = v1[2] * rcpf(1.0f + ex2(-LOG2E * v1[3]));
                    u32x2 w; w.x = pk2(o0, o1); w.y = pk2(o2, o3);
                    *(u32x2*)(MIX + (size_t)row * 1024 + 512 + (c >> 1)) = w;
                }
            }
    }
};
struct EpiRes {
    static constexpr bool PERM = true;
    const float* base32;
    float* out32;
    bf16_t* XN; float* part;
    __device__ __forceinline__ void operator()(const f32x4 (&acc)[2][2][4][2], const Unit& u, int wr, int wc, int fr, int fq) const {
        const int row0 = u.pm * 256 + wr * 64 + fr, col0 = u.pn * 256 + wc * 32 + 8 * fq;
        u32x4 bw[2][4][2];
        if (!base32) {
#pragma unroll
            for (int ai = 0; ai < 2; ++ai)
#pragma unroll
                for (int m = 0; m < 4; ++m)
#pragma unroll
                    for (int bj = 0; bj < 2; ++bj) bw[ai][m][bj] = *(const u32x4*)(XN + (size_t)(row0 + ai * 128 + m * 16) * DM + col0 + bj * 128);
        }
#pragma unroll
        for (int ai = 0; ai < 2; ++ai)
#pragma unroll
            for (int m = 0; m < 4; ++m) {
                const int row = row0 + ai * 128 + m * 16; const size_t off = (size_t)row * DM + col0; float ss = 0.f;
#pragma unroll
                for (int bj = 0; bj < 2; ++bj) {
                    f32x4 b0, b1;
                    if (base32) { b0 = __builtin_nontemporal_load((const f32x4*)(base32 + off + bj * 128)); b1 = __builtin_nontemporal_load((const f32x4*)(base32 + off + bj * 128 + 4)); }
                    else { const u32x4 w = bw[ai][m][bj]; b0 = (f32x4){bflo(w.x), bfhi(w.x), bflo(w.y), bfhi(w.y)}; b1 = (f32x4){bflo(w.z), bfhi(w.z), bflo(w.w), bfhi(w.w)}; }
                    const f32x4 x0 = b0 + acc[ai][bj][m][0], x1 = b1 + acc[ai][bj][m][1];
                    if (out32) { __builtin_nontemporal_store(x0, (f32x4*)(out32 + off + bj * 128)); __builtin_nontemporal_store(x1, (f32x4*)(out32 + off + bj * 128 + 4)); }
                    else *(u32x4*)(XN + off + bj * 128) = pack8(x0, x1);
                    ss += ((x0[0] * x0[0] + x0[1] * x0[1]) + (x0[2] * x0[2] + x0[3] * x0[3])) + ((x1[0] * x1[0] + x1[1] * x1[1]) + (x1[2] * x1[2] + x1[3] * x1[3]));
                }
                ss += __shfl_xor(ss, 16); ss += __shfl_xor(ss, 32);
                if (fq == 0) part[(size_t)row * 16 + u.pn * 4 + wc] = ss;
            }
    }
};
struct EpiFfn1 {
    static constexpr bool PERM = true;
    const LAS float* rsl; bf16_t* HID;
    __device__ __forceinline__ void operator()(const f32x4 (&acc)[2][2][4][2], const Unit& u, int wr, int wc, int fr, int fq) const {
        const int row0 = u.pm * 256 + wr * 64 + fr;
        const __amdgpu_buffer_rsrc_t hid = __builtin_amdgcn_make_buffer_rsrc(HID, 0, NTOK * FF * 2, 0x00020000);
#pragma unroll
        for (int ai = 0; ai < 2; ++ai)
#pragma unroll
            for (int m = 0; m < 4; ++m) {
                const int row = row0 + ai * 128 + m * 16; const float rs = rsl[ai * 128 + wr * 64 + m * 16 + fr];
#pragma unroll
                for (int bj = 0; bj < 2; ++bj) {
                    const int c = u.pn * 256 + bj * 128 + wc * 32 + 8 * fq;
                    f32x4 v0 = acc[ai][bj][m][0] * rs, v1 = acc[ai][bj][m][1] * rs;
#pragma unroll
                    for (int e = 0; e < 4; ++e) { const float a = fmaxf(v0[e], 0.f), b = fmaxf(v1[e], 0.f); v0[e] = a * a; v1[e] = b * b; }
                    __builtin_amdgcn_raw_buffer_store_b128(pack8(v0, v1), hid, (unsigned)(((size_t)row * FF + c) * 2), 0,   16);
                }
            }
    }
};

#define XB_TMO      128
#define XB_XCNT(j)  (256  + 64 * (j))
#define XB_XSUB(j)  (1280 + 64 * (j))
#define XB_XGEN(j)  (2304 + 64 * (j))
#define XB_TOP      3328
#define XB_TOPGEN   3392
#define XCD_BAR_WORDS 3456
#define XB_SPIN_CAP (1u << 22)
__device__ __forceinline__ unsigned xb_ld(unsigned* p)              { return __hip_atomic_load(p, __ATOMIC_RELAXED, __HIP_MEMORY_SCOPE_AGENT); }
__device__ __forceinline__ unsigned xb_add(unsigned* p, unsigned v) { return __hip_atomic_fetch_add(p, v, __ATOMIC_RELAXED, __HIP_MEMORY_SCOPE_AGENT); }
__device__ __forceinline__ unsigned xb_xcc_id() { return (unsigned)__builtin_amdgcn_s_getreg((3 << 11) | 20) & 0xFu; }
#define XB_SPIN(cond, bar) do { unsigned _sp = 0; while (cond) { __builtin_amdgcn_s_sleep(1); \
    if ((++_sp & 255u) == 0u) { if (xb_ld(&(bar)[XB_TMO])) break; if (_sp > XB_SPIN_CAP) { atomicAdd(&(bar)[XB_TMO], 1u); break; } } } } while (0)
struct XcdBarrier { unsigned* bar; unsigned x; volatile LAS unsigned* st; };
__device__ __forceinline__ XcdBarrier xcd_barrier_post(unsigned* bar, volatile LAS unsigned* st) {
    XcdBarrier b; b.bar = bar; b.x = xb_xcc_id(); b.st = st;
    if (threadIdx.x == 0) (void)xb_add(&bar[XB_XCNT(b.x)], 1u);
    return b;
}
__device__ __forceinline__ void xcd_barrier_complete(unsigned* bar, unsigned x, unsigned& nloc, unsigned& nx) {
    const unsigned G = gridDim.x * gridDim.y * gridDim.z;
    unsigned sum, cnt, mine, sp = 0u;
    for (;;) {
        sum = 0u; cnt = 0u; mine = 0u;
#pragma unroll
        for (unsigned j = 0; j < 16; ++j) { const unsigned c = xb_ld(&bar[XB_XCNT(j)]); sum += c; cnt += (c > 0u) ? 1u : 0u; mine = (j == x) ? c : mine; }
        if (sum == G) break;
        __builtin_amdgcn_s_sleep(1);
        if ((++sp & 255u) == 0u) { if (xb_ld(&bar[XB_TMO])) break; if (sp > XB_SPIN_CAP) { atomicAdd(&bar[XB_TMO], 1u); break; } }
    }
    nloc = mine > 0u ? mine : 1u; nx = cnt > 0u ? cnt : 1u;
}
__device__ __forceinline__ void xcd_barrier(const XcdBarrier& b) {
    asm volatile("s_waitcnt vmcnt(0)" ::: "memory");
    __syncthreads();
    if (threadIdx.x == 0) {
        unsigned* bar = b.bar;
        __builtin_amdgcn_s_waitcnt(0);
        unsigned nloc = b.st[0], nx = b.st[1];
        if (nloc == 0u) { xcd_barrier_complete(bar, b.x, nloc, nx); b.st[0] = nloc; b.st[1] = nx; }
        const unsigned old = xb_add(&bar[XB_XSUB(b.x)], 1u);
        const unsigned gen = old / nloc;
        if (old + 1u == (gen + 1u) * nloc) {
            __builtin_amdgcn_fence(__ATOMIC_RELEASE, "agent");
            asm volatile("s_waitcnt vmcnt(0)" ::: "memory");
            const unsigned og = xb_add(&bar[XB_TOP], 1u);
            const unsigned tg = og / nx;
            __builtin_amdgcn_fence(__ATOMIC_ACQUIRE, "agent");
            if (og + 1u == (tg + 1u) * nx) xb_add(&bar[XB_TOPGEN], 1u);
            else XB_SPIN(xb_ld(&bar[XB_TOPGEN]) == tg, bar);
            xb_add(&bar[XB_XGEN(b.x)], 1u);
            asm volatile("s_waitcnt vmcnt(0)" ::: "memory");
        } else {
            __builtin_amdgcn_fence(__ATOMIC_ACQUIRE, "agent");
            XB_SPIN(xb_ld(&bar[XB_XGEN(b.x)]) == gen, bar);
            asm volatile("s_waitcnt vmcnt(0)" ::: "memory");
        }
    }
    __syncthreads();
}

struct Args {
    const float *x, *norm1, *w_in, *q_gain, *k_gain, *sink, *lam_re, *lam_im, *log_dt, *b_re, *b_im, *c_re, *c_im, *d_skip, *w_glu, *w_out, *norm2, *w_ff1, *w_ff2;
    float* out; unsigned char* ws;
};

template <int MODE  >
__device__ __forceinline__ void p0_transpose_item(const float* W, int K, int N, const float* gain, bf16_t* WT, LAS float* scr, int item, int lane) {
    const int nblk = N / 64, kb = item / nblk, nb = item % nblk, k0 = 64 * kb, n0 = 64 * nb;
    const int lr = lane >> 4, lc = 4 * (lane & 15);
    f32x4 v[16];
#pragma unroll
    for (int i = 0; i < 16; ++i) v[i] = __builtin_nontemporal_load((const f32x4*)(W + (size_t)(k0 + 4 * i + lr) * N + n0 + lc));
#pragma unroll
    for (int i = 0; i < 16; ++i) { const int kk = 4 * i + lr; f32x4 x = v[i]; if (gain) x = x * gain[k0 + kk];
        LAS float* s = scr + kk * 65 + lc; s[0] = x[0]; s[1] = x[1]; s[2] = x[2]; s[3] = x[3]; }
    asm volatile("s_waitcnt lgkmcnt(0)" ::: "memory");
#pragma unroll
    for (int j = 0; j < 8; ++j) { const int piece = lane + 64 * j, n = piece >> 3, c = piece & 7; const LAS float* s = scr + (8 * c) * 65 + n;
        u32x4 o; o.x = pk2(s[0 * 65], s[1 * 65]); o.y = pk2(s[2 * 65], s[3 * 65]); o.z = pk2(s[4 * 65], s[5 * 65]); o.w = pk2(s[6 * 65], s[7 * 65]);
        const int nn = n0 + n; const int orow = (MODE == 1) ? (nn < 512 ? 2 * nn : 2 * (nn - 512) + 1) : nn;
        *(u32x4*)(WT + (size_t)orow * K + k0 + 8 * c) = o; }
    asm volatile("s_waitcnt lgkmcnt(0)" ::: "memory");
}

__device__ __forceinline__ f32x2 cmul(f32x2 a, f32x2 b) { return (f32x2){a.x * b.x - a.y * b.y, a.x * b.y + a.y * b.x}; }
__device__ __forceinline__ void ssm_gen(LAS unsigned char* lds, const Args& a, int layer, int g, int j8) {
    LAS f32x2* PW = (LAS f32x2*)lds;
    LAS f32x2* BB = PW + 2 * 33 * 64;
    LAS f32x2* CT = BB + 2 * 64 * 16;
    LAS float* KC = (LAS float*)(CT + 2 * 64 * 16);
    constexpr int KCS = 260;
    LAS float* DSK = KC + 2 * 32 * KCS;
    int tid_ = threadIdx.x; asm volatile("" : "+v"(tid_)); const int tid = tid_;
    bf16_t* MST = (bf16_t*)(a.ws + ((layer & 1) ? WS_MST2 : WS_MST)) + (size_t)g * 256 * 512;
    bf16_t* TOUT = (bf16_t*)(a.ws + ((layer & 1) ? WS_TOUT2 : WS_TOUT)) + (size_t)g * 512 * UK;
    f32x2* APOW = (f32x2*)(a.ws + WS_APOW) + (layer & 1) * 4096 + g * 128;
    if (tid < 16) DSK[tid] = a.d_skip[layer * 512 + g * 16 + tid];
    {
        const int p = tid & 63;
        float lrv[2], liv[2], dtv[2];
#pragma unroll
        for (int dir = 0; dir < 2; ++dir) { lrv[dir] = a.lam_re[((layer * 2 + dir) * 32 + g) * 64 + p]; liv[dir] = a.lam_im[((layer * 2 + dir) * 32 + g) * 64 + p]; dtv[dir] = __expf(a.log_dt[(layer * 2 + dir) * 32 + g]); }
#pragma unroll 1
        for (int r = 0; r < 9; ++r) {
            const int idx = tid + 512 * r;
            if (idx < 2 * 33 * 64) {
                const int dir = idx >= 33 * 64 ? 1 : 0, d = (idx - dir * 33 * 64) >> 6;
                const float lr = dir ? lrv[1] : lrv[0], li = dir ? liv[1] : liv[0], dt = dir ? dtv[1] : dtv[0];
                const float mag = __expf(lr * dt * (float)d);
                double rev = (double)li * (double)dt * 0.15915494309189535 * (double)d; rev -= __builtin_rint(rev);
                const float rv = (float)rev;
                PW[idx] = (f32x2){mag * __builtin_amdgcn_cosf(rv), mag * __builtin_amdgcn_sinf(rv)};
            }
        }
#pragma unroll
        for (int r = 0; r < 4; ++r) {
            const int i = tid + 512 * r, dir = i >> 10, pp = (i >> 4) & 63, h = i & 15;
            const float lr = a.lam_re[((layer * 2 + dir) * 32 + g) * 64 + pp], li = a.lam_im[((layer * 2 + dir) * 32 + g) * 64 + pp], dt = dir ? dtv[1] : dtv[0];
            const float mag = __expf(lr * dt);
            double rev = (double)li * (double)dt * 0.15915494309189535; rev -= __builtin_rint(rev);
            const float abx = mag * __builtin_amdgcn_cosf((float)rev), aby = mag * __builtin_amdgcn_sinf((float)rev);
            const float den = lr * lr + li * li;
            const float zr = ((abx - 1.0f) * lr + aby * li) / den, zi = (aby * lr - (abx - 1.0f) * li) / den;
            const float br = a.b_re[(((size_t)layer * 32 + g) * 64 + pp) * 16 + h], bi = a.b_im[(((size_t)layer * 32 + g) * 64 + pp) * 16 + h];
            BB[(dir * 64 + pp) * 16 + h] = (f32x2){zr * br - zi * bi, zr * bi + zi * br};
            const size_t ci = ((((size_t)layer * 2 + dir) * 32 + g) * 16 + h) * 64 + pp;
            CT[(dir * 64 + pp) * 16 + h] = (f32x2){a.c_re[ci], a.c_im[ci]};
        }
    }
    __syncthreads();
    if (j8 == 0 && tid < 128) APOW[tid] = PW[((tid >> 6) * 33 + 32) * 64 + (tid & 63)];
    const int ndf = 4 * j8 + 4;
    {
        const int wv = tid >> 6, l = tid & 63, col = l & 15, kq = l >> 4, part = kq & 1;
#pragma unroll 1
        for (int blk = wv; blk < 36; blk += 8) {
            const int dir = blk < ndf ? 0 : 1, d = dir ? blk - ndf : blk;
            f32x4 acc = {0.f, 0.f, 0.f, 0.f};
#pragma unroll 8
            for (int st = 0; st < 32; ++st) {
                const int p = 2 * st + (kq >> 1);
                const f32x2 c = CT[(dir * 64 + p) * 16 + col], w = PW[(dir * 33 + d) * 64 + p], bb = BB[(dir * 64 + p) * 16 + col];
                const float av = part ? -(c.x * w.y + c.y * w.x) : (c.x * w.x - c.y * w.y);
                const float bv = part ? bb.y : bb.x;
                acc = __builtin_amdgcn_mfma_f32_16x16x4f32(av, bv, acc, 0, 0, 0);
            }
#pragma unroll
            for (int i = 0; i < 4; ++i) KC[(dir * 32 + d) * KCS + (4 * kq + i) * 16 + col] = acc[i];
        }
    }
    __syncthreads();
#pragma unroll 1
    for (int r = 0; r < 12; ++r) {
        const int q = tid + 512 * r, n = 64 * j8 + q / 96, k0 = (q % 96) * 8, t = n >> 4, h = n & 15;
        float v[8];
        if (k0 < 512) {
            const int s = k0 >> 4, h0 = k0 & 15, d = t - s;
            if (d > 0) {
#pragma unroll
                for (int e = 0; e < 8; ++e) v[e] = KC[(0 * 32 + d) * KCS + h * 16 + h0 + e];
            } else if (d < 0) {
#pragma unroll
                for (int e = 0; e < 8; ++e) v[e] = KC[(1 * 32 - d) * KCS + h * 16 + h0 + e];
            } else {
                const float dd = DSK[h];
#pragma unroll
                for (int e = 0; e < 8; ++e) v[e] = KC[(0 * 32) * KCS + h * 16 + h0 + e] + KC[(1 * 32) * KCS + h * 16 + h0 + e] + ((h0 + e) == h ? dd : 0.f);
            }
        } else {
            const int kk = k0 - 512, dir = kk >> 7, reim = (kk >> 6) & 1, p0 = kk & 63, d = dir == 0 ? t + 1 : 32 - t;
#pragma unroll
            for (int e = 0; e < 8; ++e) { const f32x2 w = cmul(CT[(dir * 64 + p0 + e) * 16 + h], PW[(dir * 33 + d) * 64 + p0 + e]); v[e] = reim ? -w.y : w.x; }
        }
        u32x4 o; o.x = pk2(v[0], v[1]); o.y = pk2(v[2], v[3]); o.z = pk2(v[4], v[5]); o.w = pk2(v[6], v[7]);
        *(u32x4*)(TOUT + (size_t)n * UK + k0) = o;
    }
#pragma unroll 1
    for (int r = 0; r < 4; ++r) {
        const int q = tid + 512 * r, n = 32 * j8 + (q >> 6), k0 = (q & 63) * 8, s = k0 >> 4, h0 = k0 & 15, dir = n >> 7, reim = (n >> 6) & 1, p = n & 63, d = dir == 0 ? 31 - s : s;
        const f32x2 pw = PW[(dir * 33 + d) * 64 + p];
        float v[8];
#pragma unroll
        for (int e = 0; e < 8; ++e) { const f32x2 w = cmul(pw, BB[(dir * 64 + p) * 16 + h0 + e]); v[e] = reim ? w.y : w.x; }
        u32x4 o; o.x = pk2(v[0], v[1]); o.y = pk2(v[2], v[3]); o.z = pk2(v[4], v[5]); o.w = pk2(v[6], v[7]);
        *(u32x4*)(MST + (size_t)n * 512 + k0) = o;
    }
    __syncthreads();
}

__device__ __forceinline__ void carry_scan(LAS unsigned char* lds, const Args& a, int g, int b, int par) {
    int tid_ = threadIdx.x; asm volatile("" : "+v"(tid_)); const int tid = tid_;
    const int sp = tid & 127, seg = tid >> 7, dir = sp >> 6, p = sp & 63;
    const f32x2 aL = ((const f32x2*)(a.ws + WS_APOW))[par * 4096 + g * 128 + sp];
    f32x2 a64 = aL;
#pragma unroll
    for (int k = 0; k < 6; ++k) a64 = cmul(a64, a64);
    const float* S = (const float*)(a.ws + WS_S) + ((size_t)g * NCH + b * 256) * 256 + dir * 128 + p;
    bf16_t* U = (bf16_t*)(a.ws + WS_UB) + ((size_t)g * NCH + b * 256) * UK + 512 + dir * 128 + p;
    const int cbeg = dir ? 255 - seg * 64 : seg * 64, cstep = dir ? -1 : 1;
    float tr = 0.f, ti = 0.f;
#pragma unroll 1
    for (int i0 = 0; i0 < 64; i0 += 32) {
        float srv[32], siv[32];
#pragma unroll
        for (int k = 0; k < 32; ++k) { const int c = cbeg + cstep * (i0 + k); srv[k] = S[(size_t)c * 256]; siv[k] = S[(size_t)c * 256 + 64]; }
#pragma unroll
        for (int k = 0; k < 32; ++k) {
            const float nr = aL.x * tr - aL.y * ti + srv[k], ni = aL.x * ti + aL.y * tr + siv[k];
            tr = nr; ti = ni;
        }
    }
    LAS f32x2* TOT = (LAS f32x2*)lds;
    TOT[seg * 128 + sp] = (f32x2){tr, ti};
    __syncthreads();
    float cr = 0.f, ci = 0.f;
    for (int j = 0; j < seg; ++j) { const f32x2 t = TOT[j * 128 + sp]; const float nr = a64.x * cr - a64.y * ci + t.x, ni = a64.x * ci + a64.y * cr + t.y; cr = nr; ci = ni; }
#pragma unroll 1
    for (int i0 = 0; i0 < 64; i0 += 32) {
        float srv[32], siv[32];
#pragma unroll
        for (int k = 0; k < 32; ++k) { const int c = cbeg + cstep * (i0 + k); srv[k] = S[(size_t)c * 256]; siv[k] = S[(size_t)c * 256 + 64]; }
        asm volatile("" ::: "memory");
#pragma unroll
        for (int k = 0; k < 32; ++k) {
            const int c = cbeg + cstep * (i0 + k);
            U[(size_t)c * UK] = (bf16_t)(pk2(cr, 0.f) & 0xffffu); U[(size_t)c * UK + 64] = (bf16_t)(pk2(ci, 0.f) & 0xffffu);
            const float nr = aL.x * cr - aL.y * ci + srv[k], ni = aL.x * ci + aL.y * cr + siv[k];
            cr = nr; ci = ni;
        }
    }
    __syncthreads();
}

constexpr int KS_LD = 72, VT_LD = 388;
__device__ __forceinline__ int crow(int r, int hi) { return (r & 3) + 8 * (r >> 2) + 4 * hi; }
__device__ __forceinline__ void attn_unit(LAS unsigned char* lds, const Args& a, int layer, int b, int nb, int kh, float shift2) {
    int tid_ = threadIdx.x; asm volatile("" : "+v"(tid_)); const int tid = tid_, lane = tid & 63, wid = tid >> 6;
    LAS bf16_t* KS = (LAS bf16_t*)lds;
    LAS bf16_t* VT = (LAS bf16_t*)(lds + 384 * KS_LD * 2);
    const bf16_t* Qb = (const bf16_t*)(a.ws + WS_Q); const bf16_t* Kb = (const bf16_t*)(a.ws + WS_K); const bf16_t* Vb = (const bf16_t*)(a.ws + WS_V);
    bf16_t* MIX = (bf16_t*)(a.ws + WS_MIX);
    const float* qg = a.q_gain + layer * 64; const float* kg = a.k_gain + layer * 64;
    const int hq = kh * 4 + (wid >> 1), n = lane & 31, hi = lane >> 5;
    const int ib = (wid & 1) * 64;
    const size_t tok0 = (size_t)b * SEQ + nb * 128 + ib + n;
    const int part = tid & 7;
    u32x4 kraw[6], vraw[6], qraw[2][4];
#pragma unroll
    for (int r = 0; r < 6; ++r) {
        const int key = (tid >> 3) + 64 * r, pos = (nb - 1) * 128 + key;
        const size_t row = (size_t)b * SEQ + ((pos >= 0 && pos < SEQ) ? pos : 0);
        kraw[r] = *(const u32x4*)(Kb + row * 128 + kh * 64 + part * 8);
        vraw[r] = *(const u32x4*)(Vb + row * 128 + kh * 64 + part * 8);
    }
#pragma unroll
    for (int qt = 0; qt < 2; ++qt)
#pragma unroll
        for (int ks = 0; ks < 4; ++ks) qraw[qt][ks] = *(const u32x4*)(Qb + (tok0 + 32 * qt) * 512 + hq * 64 + ks * 16 + hi * 8);
    const f32x4 kg0 = *(const f32x4*)(kg + part * 8), kg1 = *(const f32x4*)(kg + part * 8 + 4);
#pragma unroll
    for (int r = 0; r < 6; ++r) {
        const int key = (tid >> 3) + 64 * r;
        const u32x4 kr = kraw[r], vr = vraw[r];
        float kf[8] = {bflo(kr.x), bfhi(kr.x), bflo(kr.y), bfhi(kr.y), bflo(kr.z), bfhi(kr.z), bflo(kr.w), bfhi(kr.w)};
        float ss = 0.f;
#pragma unroll
        for (int e = 0; e < 8; ++e) ss += kf[e] * kf[e];
        ss += __shfl_xor(ss, 1); ss += __shfl_xor(ss, 2); ss += __shfl_xor(ss, 4);
        const float sc = __builtin_amdgcn_rsqf(ss * (1.0f / 64.0f) + EPS);
        u32x4 o; o.x = pk2(kf[0] * sc * kg0[0], kf[1] * sc * kg0[1]); o.y = pk2(kf[2] * sc * kg0[2], kf[3] * sc * kg0[3]);
        o.z = pk2(kf[4] * sc * kg1[0], kf[5] * sc * kg1[1]); o.w = pk2(kf[6] * sc * kg1[2], kf[7] * sc * kg1[3]);
        *(LAS u32x4*)(KS + key * KS_LD + part * 8) = o;
        LAS bf16_t* vp = VT + (part * 8) * VT_LD + key;
        vp[0 * VT_LD] = (bf16_t)(vr.x & 0xffffu); vp[1 * VT_LD] = (bf16_t)(vr.x >> 16);
        vp[2 * VT_LD] = (bf16_t)(vr.y & 0xffffu); vp[3 * VT_LD] = (bf16_t)(vr.y >> 16);
        vp[4 * VT_LD] = (bf16_t)(vr.z & 0xffffu); vp[5 * VT_LD] = (bf16_t)(vr.z >> 16);
        vp[6 * VT_LD] = (bf16_t)(vr.w & 0xffffu); vp[7 * VT_LD] = (bf16_t)(vr.w >> 16);
    }
    __syncthreads();
    const float slope2 = ex2(-(float)(hq + 1)) * LOG2E;
    const float sinkterm = ex2(a.sink[layer * 8 + hq] * LOG2E - shift2);
    bf16x8 qf[2][4];
#pragma unroll
    for (int qt = 0; qt < 2; ++qt) {
        u32x4 qr[4]; float ss = 0.f;
#pragma unroll
        for (int ks = 0; ks < 4; ++ks) { qr[ks] = qraw[qt][ks];
#pragma unroll
            for (int e = 0; e < 4; ++e) { const float lo = bflo(qr[ks][e]), hh = bfhi(qr[ks][e]); ss += lo * lo + hh * hh; } }
        ss += __shfl_xor(ss, 32);
        const float sc = __builtin_amdgcn_rsqf(ss * (1.0f / 64.0f) + EPS) * (0.125f * LOG2E);
#pragma unroll
        for (int ks = 0; ks < 4; ++ks) {
            const f32x4 g0 = *(const f32x4*)(qg + ks * 16 + hi * 8), g1 = *(const f32x4*)(qg + ks * 16 + hi * 8 + 4);
            u32x4 o; o.x = pk2(bflo(qr[ks].x) * sc * g0[0], bfhi(qr[ks].x) * sc * g0[1]); o.y = pk2(bflo(qr[ks].y) * sc * g0[2], bfhi(qr[ks].y) * sc * g0[3]);
            o.z = pk2(bflo(qr[ks].z) * sc * g1[0], bfhi(qr[ks].z) * sc * g1[1]); o.w = pk2(bflo(qr[ks].w) * sc * g1[2], bfhi(qr[ks].w) * sc * g1[3]);
            qf[qt][ks] = __builtin_bit_cast(bf16x8, o);
        }
    }
    f32x16 oa0, oa1, ob0, ob1; float la = 0.f, lb = 0.f;
#pragma unroll
    for (int e = 0; e < 16; ++e) { oa0[e] = 0.f; oa1[e] = 0.f; ob0[e] = 0.f; ob1[e] = 0.f; }
    const int kt0 = ib >> 5;
    const float nshift = -shift2;
#pragma unroll 1
    for (int kt = kt0; kt <= kt0 + 9; ++kt) {
        const int gb = nb - 1 + (kt >> 2);
        if (gb < 0 || gb >= SEQ / 128) continue;
        f32x16 sa, sb;
#pragma unroll
        for (int e = 0; e < 16; ++e) { sa[e] = nshift; sb[e] = nshift; }
#pragma unroll
        for (int ks = 0; ks < 4; ++ks) {
            const bf16x8 ka = *(const LAS bf16x8*)(KS + (32 * kt + n) * KS_LD + ks * 16 + hi * 8);
            sa = __builtin_amdgcn_mfma_f32_32x32x16_bf16(ka, qf[0][ks], sa, 0, 0, 0);
            sb = __builtin_amdgcn_mfma_f32_32x32x16_bf16(ka, qf[1][ks], sb, 0, 0, 0);
        }
        const float ea = (float)(32 * kt - (ib + n) - 128 + 4 * hi), eb = ea - 32.0f;
        if (kt <= kt0 + 1 || kt >= kt0 + 8) {
#pragma unroll
            for (int r = 0; r < 16; ++r) {
                const float da = __builtin_fabsf(ea + (float)crow(r, 0)), db = __builtin_fabsf(eb + (float)crow(r, 0));
                const float pa = da <= 128.0f ? ex2(sa[r] - slope2 * da) : 0.f, pb = db <= 128.0f ? ex2(sb[r] - slope2 * db) : 0.f;
                la += pa; lb += pb; sa[r] = pa; sb[r] = pb;
            }
        } else {
#pragma unroll
            for (int r = 0; r < 16; ++r) {
                const float pa = ex2(sa[r] - slope2 * __builtin_fabsf(ea + (float)crow(r, 0))), pb = ex2(sb[r] - slope2 * __builtin_fabsf(eb + (float)crow(r, 0)));
                la += pa; lb += pb; sa[r] = pa; sb[r] = pb;
            }
        }
        u32x4 pa0, pa1, pb0, pb1;
        pa0.x = pk2(sa[0], sa[1]); pa0.y = pk2(sa[2], sa[3]); pa0.z = pk2(sa[4], sa[5]); pa0.w = pk2(sa[6], sa[7]);
        pa1.x = pk2(sa[8], sa[9]); pa1.y = pk2(sa[10], sa[11]); pa1.z = pk2(sa[12], sa[13]); pa1.w = pk2(sa[14], sa[15]);
        pb0.x = pk2(sb[0], sb[1]); pb0.y = pk2(sb[2], sb[3]); pb0.z = pk2(sb[4], sb[5]); pb0.w = pk2(sb[6], sb[7]);
        pb1.x = pk2(sb[8], sb[9]); pb1.y = pk2(sb[10], sb[11]); pb1.z = pk2(sb[12], sb[13]); pb1.w = pk2(sb[14], sb[15]);
        const LAS bf16_t* vb = VT + n * VT_LD + 32 * kt + 4 * hi;
        {
            const s16x4 a0 = *(const LAS s16x4*)(vb), a1 = *(const LAS s16x4*)(vb + 8);
            const s16x4 c0 = *(const LAS s16x4*)(vb + 32 * VT_LD), c1 = *(const LAS s16x4*)(vb + 32 * VT_LD + 8);
            const bf16x8 v0 = __builtin_shufflevector(a0, a1, 0, 1, 2, 3, 4, 5, 6, 7), v1 = __builtin_shufflevector(c0, c1, 0, 1, 2, 3, 4, 5, 6, 7);
            oa0 = __builtin_amdgcn_mfma_f32_32x32x16_bf16(v0, __builtin_bit_cast(bf16x8, pa0), oa0, 0, 0, 0);
            oa1 = __builtin_amdgcn_mfma_f32_32x32x16_bf16(v1, __builtin_bit_cast(bf16x8, pa0), oa1, 0, 0, 0);
            ob0 = __builtin_amdgcn_mfma_f32_32x32x16_bf16(v0, __builtin_bit_cast(bf16x8, pb0), ob0, 0, 0, 0);
            ob1 = __builtin_amdgcn_mfma_f32_32x32x16_bf16(v1, __builtin_bit_cast(bf16x8, pb0), ob1, 0, 0, 0);
        }
        {
            const s16x4 a0 = *(const LAS s16x4*)(vb + 16), a1 = *(const LAS s16x4*)(vb + 24);
            const s16x4 c0 = *(const LAS s16x4*)(vb + 32 * VT_LD + 16), c1 = *(const LAS s16x4*)(vb + 32 * VT_LD + 24);
            const bf16x8 v0 = __builtin_shufflevector(a0, a1, 0, 1, 2, 3, 4, 5, 6, 7), v1 = __builtin_shufflevector(c0, c1, 0, 1, 2, 3, 4, 5, 6, 7);
            oa0 = __builtin_amdgcn_mfma_f32_32x32x16_bf16(v0, __builtin_bit_cast(bf16x8, pa1), oa0, 0, 0, 0);
            oa1 = __builtin_amdgcn_mfma_f32_32x32x16_bf16(v1, __builtin_bit_cast(bf16x8, pa1), oa1, 0, 0, 0);
            ob0 = __builtin_amdgcn_mfma_f32_32x32x16_bf16(v0, __builtin_bit_cast(bf16x8, pb1), ob0, 0, 0, 0);
            ob1 = __builtin_amdgcn_mfma_f32_32x32x16_bf16(v1, __builtin_bit_cast(bf16x8, pb1), ob1, 0, 0, 0);
        }
    }
    la += __shfl_xor(la, 32); lb += __shfl_xor(lb, 32);
    const float inva = 1.0f / (la + sinkterm), invb = 1.0f / (lb + sinkterm);
    bf16_t* opa = MIX + tok0 * 1024 + hq * 64 + 4 * hi; bf16_t* opb = opa + 32 * 1024;
#pragma unroll
    for (int j = 0; j < 4; ++j) {
        u32x2 w0, w1, w2, w3;
        w0.x = pk2(oa0[4 * j] * inva, oa0[4 * j + 1] * inva); w0.y = pk2(oa0[4 * j + 2] * inva, oa0[4 * j + 3] * inva);
        w1.x = pk2(oa1[4 * j] * inva, oa1[4 * j + 1] * inva); w1.y = pk2(oa1[4 * j + 2] * inva, oa1[4 * j + 3] * inva);
        w2.x = pk2(ob0[4 * j] * invb, ob0[4 * j + 1] * invb); w2.y = pk2(ob0[4 * j + 2] * invb, ob0[4 * j + 3] * invb);
        w3.x = pk2(ob1[4 * j] * invb, ob1[4 * j + 1] * invb); w3.y = pk2(ob1[4 * j + 2] * invb, ob1[4 * j + 3] * invb);
        *(u32x2*)(opa + 8 * j) = w0; *(u32x2*)(opa + 32 + 8 * j) = w1; *(u32x2*)(opb + 8 * j) = w2; *(u32x2*)(opb + 32 + 8 * j) = w3;
    }
    __syncthreads();
}

__global__ void __launch_bounds__(512, 2) mk_fwd(Args a) {
    extern __shared__ __attribute__((aligned(16))) unsigned char lds_raw[];
    LAS unsigned char* lds = (LAS unsigned char*)lds_raw;
    cg::grid_group grid = cg::this_grid();
    const int G = gridDim.x;
    if (threadIdx.x < 2) ((volatile LAS unsigned*)(lds + LDS_BARST))[threadIdx.x] = 0u;
    __syncthreads();
    if (a.ws == nullptr) grid.sync();
    const XcdBarrier xbar = xcd_barrier_post((unsigned*)(a.ws + WS_BAR), (volatile LAS unsigned*)(lds + LDS_BARST));

    {
        int tid_ = threadIdx.x, bx_ = blockIdx.x; asm volatile("" : "+v"(tid_)); asm volatile("" : "+s"(bx_));
        const int tid = tid_, lane = tid & 63, wave = tid >> 6, bx = bx_, layer = 0; (void)tid;
        unsigned char* ws = a.ws;
        bf16_t* WIN = (bf16_t*)(ws + WS_WIN); bf16_t* XN = (bf16_t*)(ws + WS_XN); float* PART = (float*)(ws + WS_PART);
        {
            if (bx >= 192) {
                ssm_gen(lds, a, layer, bx >> 3, bx & 7);
                LAS float* scr = (LAS float*)(lds + wave * 16640);
                constexpr int I_IN = (DM / 64) * (INW / 64);
                for (int it = (bx - 192) * 8 + wave; it < I_IN; it += 64 * 8) p0_transpose_item<0>(a.w_in + (size_t)layer * DM * INW, DM, INW, a.norm1 + layer * DM, WIN, scr, it, lane);
            } else {
                const int gw = bx * 8 + wave, NGW = 192 * 8;
                for (int m0 = gw * 4; m0 < NTOK; m0 += NGW * 4) {
                    f32x4 v[4][4];
#pragma unroll
                    for (int q = 0; q < 4; ++q)
#pragma unroll
                        for (int j = 0; j < 4; ++j) v[q][j] = __builtin_nontemporal_load((const f32x4*)(a.x + (size_t)(m0 + q) * DM) + lane + 64 * j);
#pragma unroll
                    for (int q = 0; q < 4; ++q) {
                        float ss = 0.f; unsigned long long* o8 = (unsigned long long*)(XN + (size_t)(m0 + q) * DM) + lane;
#pragma unroll
                        for (int j = 0; j < 4; ++j) { const f32x4 w = v[q][j]; ss += (w.x * w.x + w.y * w.y) + (w.z * w.z + w.w * w.w);
                            o8[64 * j] = (unsigned long long)pk2(w.x, w.y) | ((unsigned long long)pk2(w.z, w.w) << 32); }
#pragma unroll
                        for (int o = 1; o < 64; o <<= 1) ss += __shfl_xor(ss, o);
                        if (lane < 16) PART[(size_t)(m0 + q) * 16 + lane] = lane == 0 ? ss : 0.f;
                    }
                }
            }
        }
        GSYNC();
    }
#pragma unroll 1
    for (int layer = 0; layer < DEPTH; ++layer) {
        int tid_ = threadIdx.x, bx_ = blockIdx.x; asm volatile("" : "+v"(tid_)); asm volatile("" : "+s"(bx_));
        const int tid = tid_, lane = tid & 63, wave = tid >> 6, bx = bx_; (void)tid;
        const int par = layer & 1;
        unsigned char* ws = a.ws; asm volatile("" : "+s"(ws));
        bf16_t* WGLU = (bf16_t*)(ws + WS_WGLU); bf16_t* WOUT = (bf16_t*)(ws + WS_WOUT); bf16_t* W1 = (bf16_t*)(ws + WS_W1); bf16_t* W2 = (bf16_t*)(ws + WS_W2);
        bf16_t* XN = (bf16_t*)(ws + WS_XN); bf16_t* HID = (bf16_t*)(ws + WS_HID); bf16_t* MIX = (bf16_t*)(ws + WS_MIX); bf16_t* YB = (bf16_t*)(ws + WS_Y); bf16_t* UB = (bf16_t*)(ws + WS_UB);
        float* PART = (float*)(ws + WS_PART);
        bf16_t* WIN = (bf16_t*)(ws + (par ? WS_WIN2 : WS_WIN)); bf16_t* WINN = (bf16_t*)(ws + (par ? WS_WIN : WS_WIN2));
        for (int rp = 0; rp < REP_P1; ++rp) {
            pg8::Gemm g{XN, WIN, DM, DM, DM, 0, 0}; pg8::StaticOrder S; S.init(NTOK, INW, G, bx);
            LAS float* rsl = (LAS float*)(lds + 131072);
            Unit u0, u1; int pm0 = 0;
            pg8::RsPre pre{PART, rsl, 0, 0, 0};
            if (S.next(0, u0)) { pm0 = u0.pm; const bool two = S.next(1, u1); pre.pm0 = u0.pm; pre.pm1 = two ? u1.pm : u0.pm; pre.ntab = two ? 2 : 1; }
            EpiInProj E{rsl, pm0, (bf16_t*)(ws + WS_Q), (bf16_t*)(ws + WS_K), (bf16_t*)(ws + WS_V), UB};
            pg8::gemm_phase<EpiInProj, pg8::StaticOrder, true, true, pg8::RsPre>(lds, g, S, E, pre);
            if (bx >= 64 && rp == 0) {
                LAS float* scr = (LAS float*)(lds + wave * 16640);
                const int gw = (bx - 64) * 8 + wave, NGW = (G - 64) * 8;
                constexpr int I_GLU = (512 / 64) * (1024 / 64), I_OUT = (DM / 64) * (DM / 64), I_1 = (DM / 64) * (FF / 64), I_2 = (FF / 64) * (DM / 64);
                for (int it = gw; it < I_GLU + I_OUT + I_1 + I_2; it += NGW) {
                    int r = it;
                    if (r < I_GLU) { p0_transpose_item<1>(a.w_glu + (size_t)layer * 512 * 1024, 512, 1024, nullptr, WGLU, scr, r, lane); continue; } r -= I_GLU;
                    if (r < I_OUT) { p0_transpose_item<0>(a.w_out + (size_t)layer * DM * DM, DM, DM, nullptr, WOUT, scr, r, lane); continue; } r -= I_OUT;
                    if (r < I_1) { p0_transpose_item<0>(a.w_ff1 + (size_t)layer * DM * FF, DM, FF, a.norm2 + layer * DM, W1, scr, r, lane); continue; } r -= I_1;
                    p0_transpose_item<0>(a.w_ff2 + (size_t)layer * FF * DM, FF, DM, nullptr, W2, scr, r, lane);
                }
                if (layer + 1 < DEPTH) for (int it = gw; it < (DM / 64) * (INW / 64); it += NGW) p0_transpose_item<0>(a.w_in + (size_t)(layer + 1) * DM * INW, DM, INW, a.norm1 + (layer + 1) * DM, WINN, scr, it, lane);
                __syncthreads(); ssm_gen(lds, a, layer, (bx - 64) >> 3, (bx - 64) & 7);
            }
        }
        GSYNC();
        {
#define ATTN_SHIFT2(var) float var; { int ln_ = threadIdx.x & 63; asm volatile("" : "+v"(ln_)); float mq = fabsf(a.q_gain[layer * 64 + ln_]), mk = fabsf(a.k_gain[layer * 64 + ln_]); \
            _Pragma("unroll") for (int o = 1; o < 64; o <<= 1) { mq = fmaxf(mq, __shfl_xor(mq, o)); mk = fmaxf(mk, __shfl_xor(mk, o)); } var = 8.0f * mq * mk * LOG2E; }
            unsigned* flags = (unsigned*)(ws + WS_FLAG);
            const unsigned epoch = (unsigned)layer + 1u;
            if (bx < 64) {
                pg8::Gemm g{UB, (const bf16_t*)(ws + (par ? WS_MST2 : WS_MST)), UK, 512, 512, (size_t)NCH * UK, (size_t)256 * 512};
                const int cm = (bx & 7) * 8 + (bx >> 3);
                pg8::BatchOrder S{64, cm, 64, 2, 1};
                EpiState E{(float*)(ws + WS_S)};
                pg8::gemm_phase<EpiState, pg8::BatchOrder>(lds, g, S, E);
                asm volatile("s_waitcnt vmcnt(0)" ::: "memory"); __syncthreads();
                carry_scan(lds, a, cm >> 1, cm & 1, par);
                asm volatile("s_waitcnt vmcnt(0)" ::: "memory"); __syncthreads();
                if (tid == 0) { __builtin_amdgcn_fence(__ATOMIC_RELEASE, "agent"); asm volatile("s_waitcnt vmcnt(0)" ::: "memory"); __hip_atomic_store(flags + 64 * cm, epoch, __ATOMIC_RELAXED, __HIP_MEMORY_SCOPE_AGENT); }
                { const int u = 192 + (bx & 7) * 8 + (bx >> 3); ATTN_SHIFT2(shift2); attn_unit(lds, a, layer, u >> 7, (u >> 1) & 63, u & 1, shift2); }
            } else if (bx < 192) {
                const int v = bx - 64;
                { const int u = (v & 7) * 16 + (v >> 3); ATTN_SHIFT2(shift2); attn_unit(lds, a, layer, u >> 7, (u >> 1) & 63, u & 1, shift2); }
                const int cs = (v & 7) * 16 + (v >> 3);
                pg8::Gemm g{UB, (const bf16_t*)(ws + (par ? WS_TOUT2 : WS_TOUT)), UK, UK, UK, (size_t)NCH * UK, (size_t)512 * UK};
                pg8::GatedBatchOrder S; S.G = 128; S.c = cs; S.total = 128; S.npm = 2; S.npn = 2; S.flag = flags + 64 * ((cs >> 2) * 2 + ((cs >> 1) & 1)); S.epoch = epoch;
                EpiSsmOut E{YB};
                pg8::gemm_phase<EpiSsmOut, pg8::GatedBatchOrder>(lds, g, S, E);
            } else {
                { const int v = bx - 192, u = 128 + (v & 7) * 8 + (v >> 3); ATTN_SHIFT2(shift2); attn_unit(lds, a, layer, u >> 7, (u >> 1) & 63, u & 1, shift2); }
                if (layer + 1 < DEPTH) ssm_gen(lds, a, layer + 1, bx >> 3, bx & 7);
            }
        }
        GSYNC();
        for (int rp = 0; rp < REP_P5; ++rp) {
            pg8::Gemm g{YB, WGLU, 512, 512, 512, 0, 0}; pg8::StaticOrder S; S.init(NTOK, 1024, G, bx);
            EpiGlu E{MIX};
            pg8::gemm_phase<EpiGlu, pg8::StaticOrder>(lds, g, S, E);
        }
        GSYNC();
        {
            pg8::Gemm g{MIX, WOUT, DM, DM, DM, 0, 0}; pg8::StaticOrder S; S.init(NTOK, DM, G, bx);
            EpiRes E{layer == 0 ? a.x : nullptr, nullptr, XN, PART};
            pg8::gemm_phase<EpiRes, pg8::StaticOrder>(lds, g, S, E);
        }
        GSYNC();
        for (int rp = 0; rp < REP_P7; ++rp) {
            pg8::Gemm g{XN, W1, DM, DM, DM, 0, 0}; pg8::StaticOrder S; S.init(NTOK, FF, G, bx);
            LAS float* rsl = (LAS float*)(lds + 131072);
            pg8::RsPre pre{PART, rsl, 0, 0, 0};
            { Unit u0; if (S.next(0, u0)) { pre.pm0 = u0.pm; pre.ntab = 1; } }
            EpiFfn1 E{rsl, HID};
            pg8::gemm_phase<EpiFfn1, pg8::StaticOrder, true, true, pg8::RsPre>(lds, g, S, E, pre);
        }
        GSYNC();
        {
            pg8::Gemm g{HID, W2, FF, FF, FF, 0, 0}; pg8::StaticOrder S; S.init(NTOK, DM, G, bx);
            EpiRes E{nullptr, layer == DEPTH - 1 ? a.out : nullptr, XN, PART};
            pg8::gemm_phase<EpiRes, pg8::StaticOrder>(lds, g, S, E);
        }
        if (layer + 1 < DEPTH) GSYNC();
    }
}

extern "C" void kernel_launch(void* const* d_in, const int* in_sizes, int n_in, void* d_out, int out_size, void* d_ws, size_t ws_size, hipStream_t stream) {
    static int grid = 0;
    if (grid == 0) {
        if (n_in != 19 || in_sizes[0] != NTOK * DM || out_size != NTOK * DM || ws_size < WS_END) { fprintf(stderr, "kernel_launch: unexpected shapes (n_in %d, ws %zu)\n", n_in, ws_size); grid = -1; return; }
        int dev = 0, cus = 0, per_cu = 0;
        hipGetDevice(&dev); hipDeviceGetAttribute(&cus, hipDeviceAttributeMultiprocessorCount, dev);
        if (hipFuncSetAttribute((const void*)mk_fwd, hipFuncAttributeMaxDynamicSharedMemorySize, LDS_BYTES) != hipSuccess) { fprintf(stderr, "kernel_launch: hipFuncSetAttribute failed\n"); grid = -1; return; }
        if (hipOccupancyMaxActiveBlocksPerMultiprocessor(&per_cu, (const void*)mk_fwd, 512, LDS_BYTES) != hipSuccess || per_cu < 1) { fprintf(stderr, "kernel_launch: occupancy query gives %d\n", per_cu); per_cu = 1; }
        (void)hipGetLastError();
        if (cus < 256) { fprintf(stderr, "kernel_launch: built for a 256-CU device, found %d CUs\n", cus); grid = -1; return; }
        grid = 256;
    }
    if (grid < 0) return;
    if (hipMemsetAsync((char*)d_ws, 0, 131072, stream) != hipSuccess) { fprintf(stderr, "kernel_launch: memset failed\n"); return; }
    Args a{};
    const float** ap = (const float**)&a;
    for (int i = 0; i < 19; ++i) ap[i] = (const float*)d_in[i];
    a.out = (float*)d_out; a.ws = (unsigned char*)d_ws;
    void* args[] = {&a};
    hipError_t e = hipLaunchCooperativeKernel((const void*)mk_fwd, dim3(grid), dim3(512), args, LDS_BYTES, stream);
    if (e != hipSuccess) fprintf(stderr, "cooperative launch failed: %s (grid %d)\n", hipGetErrorString(e), grid);
}
```

```cpp
#include <hip/hip_runtime.h>
#include <hip/hip_cooperative_groups.h>
#include <cstdio>
#include <cstdint>
namespace cg = cooperative_groups;

#define LAS __attribute__((address_space(3)))
typedef unsigned short bf16_t;
typedef short bf16x8 __attribute__((ext_vector_type(8)));
typedef short s16x4 __attribute__((ext_vector_type(4)));
typedef float f32x4 __attribute__((ext_vector_type(4)));
typedef float f32x2 __attribute__((ext_vector_type(2)));
typedef float f32x16 __attribute__((ext_vector_type(16)));
typedef unsigned u32x4 __attribute__((ext_vector_type(4)));
typedef unsigned u32x2 __attribute__((ext_vector_type(2)));
typedef __bf16 bf2_t __attribute__((ext_vector_type(2)));

constexpr int NTOK = 16384, SEQ = 8192, DM = 1024, INW = 1280, FF = 4096, DEPTH = 4;
constexpr int CH = 32;
constexpr int NCH = NTOK / CH;
constexpr int UK = CH * 16 + 256;
constexpr float EPS = 1e-6f;
constexpr float LOG2E = 1.4426950408889634f;

constexpr size_t MiB = 1u << 20;
constexpr size_t WS_WIN = 1 * MiB;
constexpr size_t WS_WGLU = WS_WIN + 5 * MiB / 2;
constexpr size_t WS_WOUT = WS_WGLU + 1 * MiB;
constexpr size_t WS_W1 = WS_WOUT + 2 * MiB;
constexpr size_t WS_W2 = WS_W1 + 8 * MiB;
constexpr size_t WS_MST = 24 * MiB;
constexpr size_t WS_TOUT = 32 * MiB;
constexpr size_t WS_XN = 56 * MiB;
constexpr size_t WS_HID = 88 * MiB;
constexpr size_t WS_Q = 88 * MiB;
constexpr size_t WS_K = 104 * MiB;
constexpr size_t WS_V = 108 * MiB;
constexpr size_t WS_UB = 112 * MiB;
constexpr size_t WS_S = 136 * MiB;
constexpr size_t WS_Y = 152 * MiB;
constexpr size_t WS_MIX = 168 * MiB;
constexpr size_t WS_PART = 216 * MiB;
constexpr size_t WS_APOW = 218 * MiB;
constexpr size_t WS_TOUT2 = 220 * MiB;
constexpr size_t WS_MST2 = 244 * MiB;
constexpr size_t WS_WIN2 = 252 * MiB;
constexpr size_t WS_END = 255 * MiB;

constexpr int LDS_BYTES = 147456;
constexpr int REP_SYNC = 1, REP_P0 = 1, REP_P1 = 1, REP_P2 = 1, REP_P4 = 1, REP_P5 = 1, REP_P7 = 1, REP_P0A = 1, REP_P0B = 1, REP_P2A = 1, REP_P2B = 1;
#define GSYNC() do { for (int rs_ = 0; rs_ < REP_SYNC; ++rs_) xcd_barrier(xbar); } while (0)
constexpr size_t WS_FLAG = 32768;
constexpr size_t WS_BAR = 65536;
constexpr int LDS_BARST = LDS_BYTES - 64;

__device__ __forceinline__ unsigned pk2(float lo, float hi) { f32x2 v = {lo, hi}; bf2_t b = __builtin_convertvector(v, bf2_t); return __builtin_bit_cast(unsigned, b); }
__device__ __forceinline__ float bflo(unsigned w) { return __builtin_bit_cast(float, w << 16); }
__device__ __forceinline__ float bfhi(unsigned w) { return __builtin_bit_cast(float, w & 0xffff0000u); }
__device__ __forceinline__ float ex2(float x) { return __builtin_amdgcn_exp2f(x); }
__device__ __forceinline__ float rcpf(float x) { return __builtin_amdgcn_rcpf(x); }

namespace pg8 {
constexpr int BM = 256, BK = 64, HALF = 128, HTB = HALF * BK * 2, STAGE_BYTES = 8 * HTB, NXCD = 8, WGM = 8;
__host__ __device__ __forceinline__ int lds_byte(int r, int c) { const int st = (r >> 4) * 2 + (c >> 5), rr = r & 15, cc = c & 31, ob = rr * 64 + cc * 2; return st * 1024 + (ob ^ (((ob >> 9) & 1) << 5)); }
__host__ __device__ __forceinline__ void stage_rc(int b, int& R, int& C) { const int st = b / 1024, sb = b % 1024, swz = sb ^ (((sb >> 9) & 1) << 5); R = (st >> 1) * 16 + swz / 64; C = (st & 1) * 32 + (swz % 64) / 2; }
__host__ __device__ __forceinline__ int perm32(int rho) { const int n = rho >> 4, i = rho & 15; return 8 * (i >> 2) + 4 * n + (i & 3); }

struct Unit { int pm, pn, g; };
struct Gemm { const bf16_t* A; const bf16_t* Bt; int lda, ldb, K; size_t gsA, gsB; };

struct StaticOrder {
    int nM, nN, nwg, G, c;
    __device__ void init(int M, int N, int G_, int c_) { nM = M / BM; nN = N / BM; nwg = nM * nN; G = G_; c = c_; }
    __device__ bool next(int i, Unit& u) const {
        const long L = (long)i * G + c; if (L >= nwg) return false;
        int wgid = (int)L; { const int q = nwg / NXCD, r = nwg % NXCD, xcd = wgid % NXCD, off = wgid / NXCD; wgid = (xcd < r ? xcd * (q + 1) : r * (q + 1) + (xcd - r) * q) + off; }
        const int nig = WGM * nN, gid = wgid / nig, fm = gid * WGM, gsz = (nM - fm) < WGM ? (nM - fm) : WGM;
        u.pm = fm + ((wgid % nig) % gsz); u.pn = (wgid % nig) / gsz; u.g = 0; return true;
    }
    __device__ __forceinline__ void k_hook(int, int) const {}
};
struct BatchOrder {
    int G, c, total, npm, npn;
    __device__ bool next(int i, Unit& u) const {
        const int L = i * G + c; if (L >= total || c >= G) return false;
        const int per = npm * npn; u.g = L / per; const int r = L % per; u.pm = r / npn; u.pn = r % npn; return true;
    }
    __device__ __forceinline__ void k_hook(int, int) const {}
};
struct GatedBatchOrder : BatchOrder {
    unsigned* flag; unsigned epoch; static constexpr int tgate = 6;
    __device__ __forceinline__ void k_hook(int t, int wid) const {
        if (t == tgate) {
            if (wid == 0) {
                unsigned sp = 0;
                while ((unsigned)__builtin_amdgcn_readfirstlane(__hip_atomic_load(flag, __ATOMIC_RELAXED, __HIP_MEMORY_SCOPE_AGENT)) != epoch) { __builtin_amdgcn_s_sleep(2); if (++sp > (1u << 22)) break; }
                __builtin_amdgcn_fence(__ATOMIC_ACQUIRE, "agent");
                asm volatile("s_waitcnt vmcnt(0)" ::: "memory");
            }
            asm volatile("" ::: "memory"); __builtin_amdgcn_s_barrier(); asm volatile("" ::: "memory");
        }
    }
};

struct NoPre { __device__ __forceinline__ void operator()() const {} };
struct RsPre {
    const float* part; LAS float* rsl; int pm0, pm1; int ntab;
    __device__ __forceinline__ void operator()() const {
        const int tid = threadIdx.x;
        if (tid < 256 * ntab) { const f32x4* p = (const f32x4*)(part + ((size_t)((tid < 256 ? pm0 : pm1) * 256 + (tid & 255))) * 16); const f32x4 a = p[0], b = p[1], c = p[2], d = p[3];
            const float s = (((a.x + a.y) + (a.z + a.w)) + ((b.x + b.y) + (b.z + b.w))) + (((c.x + c.y) + (c.z + c.w)) + ((d.x + d.y) + (d.z + d.w))); rsl[tid] = __builtin_amdgcn_rsqf(s * (1.0f / 1024.0f) + 1e-6f); }
    }
};
template <class Epi, class Sched, bool ALIGN_EPI = true, bool SP2 = true, class Pre = NoPre>
__device__ __forceinline__ void gemm_phase(LAS unsigned char* lds, const Gemm g, const Sched& S, const Epi& E, const Pre& pre = Pre()) {
    int tid_ = threadIdx.x; asm volatile("" : "+v"(tid_));
    const int tid = tid_, wid = __builtin_amdgcn_readfirstlane(tid >> 6), lane = tid & 63, wr = wid >> 2, wc = wid & 3, fr = lane & 15, fq = lane >> 4;
    const int nt = g.K / BK;
    unsigned voffA[2], voffB[2];
#pragma unroll
    for (int i = 0; i < 2; ++i) { int R, C; stage_rc(tid * 16 + i * 8192, R, C); const int Rb = Epi::PERM ? ((R & ~31) + perm32(R & 31)) : R;
        voffA[i] = (unsigned)(R * g.lda + C) * 2u; voffB[i] = (unsigned)(Rb * g.ldb + C) * 2u; }
    const size_t kstep = (size_t)(BK * 2);
    const size_t hsA = (size_t)HALF * g.lda * 2, hsB = (size_t)HALF * g.ldb * 2;
    const unsigned ldsw = (unsigned)wid * 1024u;
    const int aoff = lds_byte(wr * 64 + fr, fq * 8), boff = lds_byte(wc * 32 + fr, fq * 8);
#define PG8_TILE_A(u) ((const char*)g.A + ((size_t)(u).g * g.gsA + (size_t)(u).pm * BM * g.lda) * 2)
#define PG8_TILE_B(u) ((const char*)g.Bt + ((size_t)(u).g * g.gsB + (size_t)(u).pn * BM * g.ldb) * 2)
#define PG8_SA(b, h) (((b) * 2 + (h)) * HTB)
#define PG8_SB(b, h) ((4 + (b) * 2 + (h)) * HTB)
#define PG8_STAGE(bufoff, gbase, voff) do { _Pragma("unroll") for (int _i = 0; _i < 2; ++_i) \
        __builtin_amdgcn_global_load_lds((const unsigned*)((const char*)(gbase) + (voff)[_i]), (LAS unsigned*)(lds + (bufoff) + ldsw + _i * 8192), 16, 0, 0); } while (0)
#define PG8_LDA(dst, b, h) do { _Pragma("unroll") for (int m = 0; m < 4; ++m) _Pragma("unroll") for (int k = 0; k < 2; ++k) dst[m][k] = *(const LAS bf16x8*)(lds + PG8_SA(b, h) + aoff + m * 2048 + k * 1024); } while (0)
#define PG8_LDB(dst, b, h) do { _Pragma("unroll") for (int n = 0; n < 2; ++n) _Pragma("unroll") for (int k = 0; k < 2; ++k) dst[n][k] = *(const LAS bf16x8*)(lds + PG8_SB(b, h) + boff + n * 2048 + k * 1024); } while (0)
#define PG8_MMA(ai, bj, At, Bt) do { __builtin_amdgcn_s_setprio(1); _Pragma("unroll") for (int m = 0; m < 4; ++m) _Pragma("unroll") for (int n = 0; n < 2; ++n) _Pragma("unroll") for (int k = 0; k < 2; ++k) \
        acc[ai][bj][m][n] = __builtin_amdgcn_mfma_f32_16x16x32_bf16(Bt[n][k], At[m][k], acc[ai][bj][m][n], 0, 0, 0); __builtin_amdgcn_s_setprio(0); } while (0)
#define PG8_WAIT_V(n) asm volatile("s_waitcnt vmcnt(" #n ")" ::: "memory")
#define PG8_WAIT_L(n) asm volatile("s_waitcnt lgkmcnt(" #n ")" ::: "memory")
#define PG8_BAR __builtin_amdgcn_s_barrier()
#define PG8_SCHED __builtin_amdgcn_sched_barrier(0)
    Unit cur, nxt; int ui = 0;
    if (!S.next(0, cur)) return;
    f32x4 acc[2][2][4][2];
#pragma unroll
    for (int a = 0; a < 2; ++a)
#pragma unroll
        for (int b = 0; b < 2; ++b)
#pragma unroll
            for (int m = 0; m < 4; ++m)
#pragma unroll
                for (int n = 0; n < 2; ++n) acc[a][b][m][n] = (f32x4){0.f, 0.f, 0.f, 0.f};
    bf16x8 At[4][2], B0[2][2], B1[2][2];
    const char* cA = PG8_TILE_A(cur); const char* cB = PG8_TILE_B(cur);
    if constexpr (SP2) {
        PG8_STAGE(PG8_SB(0, 0), cB, voffB); PG8_STAGE(PG8_SB(0, 1), cB + hsB, voffB); PG8_STAGE(PG8_SA(0, 0), cA, voffA); PG8_STAGE(PG8_SA(0, 1), cA + hsA, voffA);
        pre();
        if (wr == 1) PG8_BAR;
        PG8_WAIT_V(2); PG8_BAR;
        PG8_STAGE(PG8_SB(1, 0), cB + kstep, voffB); PG8_STAGE(PG8_SA(1, 0), cA + kstep, voffA); PG8_STAGE(PG8_SB(1, 1), cB + hsB + kstep, voffB);
        PG8_WAIT_V(6); PG8_BAR;
    } else {
        PG8_STAGE(PG8_SB(0, 0), cB, voffB); PG8_STAGE(PG8_SA(0, 0), cA, voffA); PG8_STAGE(PG8_SB(0, 1), cB + hsB, voffB); PG8_STAGE(PG8_SA(0, 1), cA + hsA, voffA);
        if (wr == 1) PG8_BAR;
        PG8_WAIT_V(4); PG8_BAR;
        PG8_STAGE(PG8_SB(1, 0), cB + kstep, voffB); PG8_STAGE(PG8_SA(1, 0), cA + kstep, voffA); PG8_STAGE(PG8_SB(1, 1), cB + hsB + kstep, voffB);
        PG8_WAIT_V(6); PG8_BAR;
    }
    for (;;) {
        const bool has_next = S.next(ui + 1, nxt);
        const char* nA = has_next ? PG8_TILE_A(nxt) : cA; const char* nB = has_next ? PG8_TILE_B(nxt) : cB;
        for (int t = 0; t < nt; t += 2) {
            S.k_hook(t, wid);
            const bool last = (t == nt - 2);
            const char* a1 = cA + (size_t)(t + 1) * kstep;
            const char* a2 = last ? nA : cA + (size_t)(t + 2) * kstep; const char* b2 = last ? nB : cB + (size_t)(t + 2) * kstep;
            const char* a3 = a2 + kstep; const char* b3 = b2 + kstep;
            if constexpr (SP2) {
            PG8_LDB(B0, 0, 0); PG8_LDB(B1, 0, 1); PG8_SCHED; PG8_LDA(At, 0, 0); PG8_STAGE(PG8_SA(1, 1), a1 + hsA, voffA);
            PG8_WAIT_V(8); PG8_WAIT_L(0); PG8_BAR; PG8_MMA(0, 0, At, B0); PG8_MMA(0, 1, At, B1); PG8_BAR; PG8_SCHED;
            PG8_LDA(At, 0, 1); PG8_STAGE(PG8_SB(0, 0), b2, voffB); PG8_STAGE(PG8_SB(0, 1), b2 + hsB, voffB); PG8_STAGE(PG8_SA(0, 0), a2, voffA);
            PG8_WAIT_V(8); PG8_WAIT_L(0); PG8_BAR; PG8_MMA(1, 0, At, B0); PG8_MMA(1, 1, At, B1); PG8_BAR; PG8_SCHED;
            PG8_LDB(B0, 1, 0); PG8_LDB(B1, 1, 1); PG8_SCHED; PG8_LDA(At, 1, 0); PG8_STAGE(PG8_SA(0, 1), a2 + hsA, voffA);
            PG8_WAIT_V(8); PG8_WAIT_L(0); PG8_BAR; PG8_MMA(0, 0, At, B0); PG8_MMA(0, 1, At, B1); PG8_BAR; PG8_SCHED;
            PG8_LDA(At, 1, 1); PG8_STAGE(PG8_SB(1, 0), b3, voffB); PG8_STAGE(PG8_SB(1, 1), b3 + hsB, voffB); PG8_STAGE(PG8_SA(1, 0), a3, voffA);
            PG8_WAIT_V(8); PG8_WAIT_L(0); PG8_BAR; PG8_MMA(1, 0, At, B0); PG8_MMA(1, 1, At, B1); PG8_BAR; PG8_SCHED;
            } else {
            PG8_LDB(B0, 0, 0); PG8_SCHED; PG8_LDA(At, 0, 0); PG8_STAGE(PG8_SA(1, 1), a1 + hsA, voffA);
            PG8_WAIT_L(8); PG8_BAR; PG8_WAIT_L(0); PG8_MMA(0, 0, At, B0); PG8_BAR; PG8_SCHED;
            PG8_LDB(B1, 0, 1); PG8_STAGE(PG8_SB(0, 0), b2, voffB);
            PG8_BAR; PG8_WAIT_L(0); PG8_MMA(0, 1, At, B1); PG8_BAR;
            PG8_LDA(At, 0, 1); PG8_STAGE(PG8_SA(0, 0), a2, voffA);
            PG8_BAR; PG8_WAIT_L(0); PG8_MMA(1, 0, At, B0); PG8_BAR; PG8_SCHED;
            PG8_STAGE(PG8_SB(0, 1), b2 + hsB, voffB);
            PG8_WAIT_V(6); PG8_BAR; PG8_MMA(1, 1, At, B1); PG8_BAR;
            PG8_LDB(B0, 1, 0); PG8_SCHED; PG8_LDA(At, 1, 0); PG8_STAGE(PG8_SA(0, 1), a2 + hsA, voffA);
            PG8_WAIT_L(8); PG8_BAR; PG8_WAIT_L(0); PG8_MMA(0, 0, At, B0); PG8_BAR; PG8_SCHED;
            PG8_LDB(B1, 1, 1); PG8_STAGE(PG8_SB(1, 0), b3, voffB);
            PG8_BAR; PG8_WAIT_L(0); PG8_MMA(0, 1, At, B1); PG8_BAR;
            PG8_LDA(At, 1, 1); PG8_STAGE(PG8_SA(1, 0), a3, voffA);
            PG8_BAR; PG8_WAIT_L(0); PG8_MMA(1, 0, At, B0); PG8_BAR; PG8_SCHED;
            PG8_STAGE(PG8_SB(1, 1), b3 + hsB, voffB);
            PG8_WAIT_V(6); PG8_BAR; PG8_MMA(1, 1, At, B1); PG8_BAR;
            }
        }
        if constexpr (ALIGN_EPI) { if (wr == 0) PG8_BAR; }
        E(acc, cur, wr, wc, fr, fq);
        if (!has_next) break;
#pragma unroll
        for (int a = 0; a < 2; ++a)
#pragma unroll
            for (int b = 0; b < 2; ++b)
#pragma unroll
                for (int m = 0; m < 4; ++m)
#pragma unroll
                    for (int n = 0; n < 2; ++n) acc[a][b][m][n] = (f32x4){0.f, 0.f, 0.f, 0.f};
        cur = nxt; cA = nA; cB = nB; ++ui;
        if constexpr (ALIGN_EPI) { if (wr == 1) PG8_BAR; }
    }
    PG8_WAIT_V(0);
    if constexpr (!ALIGN_EPI) { if (wr == 0) PG8_BAR; }
    PG8_BAR;
#undef PG8_TILE_A
#undef PG8_TILE_B
#undef PG8_SA
#undef PG8_SB
#undef PG8_STAGE
#undef PG8_LDA
#undef PG8_LDB
#undef PG8_MMA
#undef PG8_WAIT_V
#undef PG8_WAIT_L
#undef PG8_BAR
#undef PG8_SCHED
}
}
using pg8::Unit;

__device__ __forceinline__ float row_rs(const float* part, int row) {
    const f32x4* p = (const f32x4*)(part + (size_t)row * 16);
    const f32x4 a = p[0], b = p[1], c = p[2], d = p[3];
    const float s = (((a.x + a.y) + (a.z + a.w)) + ((b.x + b.y) + (b.z + b.w))) + (((c.x + c.y) + (c.z + c.w)) + ((d.x + d.y) + (d.z + d.w)));
    return __builtin_amdgcn_rsqf(s * (1.0f / 1024.0f) + EPS);
}
__device__ __forceinline__ u32x4 pack8(f32x4 v0, f32x4 v1) { u32x4 w; w.x = pk2(v0[0], v0[1]); w.y = pk2(v0[2], v0[3]); w.z = pk2(v1[0], v1[1]); w.w = pk2(v1[2], v1[3]); return w; }

struct EpiInProj {
    static constexpr bool PERM = true;
    const LAS float* rsl; int pm0; bf16_t *Q, *K, *V, *UB;
    __device__ __forceinline__ void operator()(const f32x4 (&acc)[2][2][4][2], const Unit& u, int wr, int wc, int fr, int fq) const {
        const int row0 = u.pm * 256 + wr * 64 + fr;
        const LAS float* rt = rsl + (u.pm == pm0 ? 0 : 256);
#pragma unroll
        for (int ai = 0; ai < 2; ++ai)
#pragma unroll
            for (int m = 0; m < 4; ++m) {
                const int row = row0 + ai * 128 + m * 16; const float rs = rt[ai * 128 + wr * 64 + m * 16 + fr];
#pragma unroll
                for (int bj = 0; bj < 2; ++bj) {
                    const int cb = bj * 128 + wc * 32 + 8 * fq;
                    const u32x4 w = pack8(acc[ai][bj][m][0] * rs, acc[ai][bj][m][1] * rs);
                    bf16_t* dst;
                    if (u.pn < 2) dst = Q + (size_t)row * 512 + u.pn * 256 + cb;
                    else if (u.pn == 2) dst = (bj == 0 ? K : V) + (size_t)row * 128 + wc * 32 + 8 * fq;
                    else { const int j = (u.pn - 3) * 256 + cb, g = j >> 4, h = j & 15; dst = UB + ((size_t)(g * NCH + (row >> 5)) * UK + (row & 31) * 16 + h); }
                    *(u32x4*)dst = w;
                }
            }
    }
};
struct EpiState {
    static constexpr bool PERM = false;
    float* S;
    __device__ __forceinline__ void operator()(const f32x4 (&acc)[2][2][4][2], const Unit& u, int wr, int wc, int fr, int fq) const {
        const int row0 = u.pm * 256 + wr * 64 + fr;
#pragma unroll
        for (int ai = 0; ai < 2; ++ai)
#pragma unroll
            for (int m = 0; m < 4; ++m) {
                float* rp = S + ((size_t)u.g * NCH + row0 + ai * 128 + m * 16) * 256 + wc * 32 + 4 * fq;
#pragma unroll
                for (int bj = 0; bj < 2; ++bj)
#pragma unroll
                    for (int n = 0; n < 2; ++n) *(f32x4*)(rp + bj * 128 + n * 16) = acc[ai][bj][m][n];
            }
    }
};
__device__ __forceinline__ float gelu_tanh(float x) {
    const float t = x + 0.044715f * x * x * x;
    return x * rcpf(1.0f + ex2(-1.5957691216057308f * LOG2E * t));
}
struct EpiSsmOut {
    static constexpr bool PERM = true;
    bf16_t* Y;
    __device__ __forceinline__ void operator()(const f32x4 (&acc)[2][2][4][2], const Unit& u, int wr, int wc, int fr, int fq) const {
        const int row0 = u.pm * 256 + wr * 64 + fr;
#pragma unroll
        for (int ai = 0; ai < 2; ++ai)
#pragma unroll
            for (int m = 0; m < 4; ++m) {
                const int chunk = row0 + ai * 128 + m * 16;
#pragma unroll
                for (int bj = 0; bj < 2; ++bj) {
                    const int c = u.pn * 256 + bj * 128 + wc * 32 + 8 * fq, t = c >> 4, h = c & 15;
                    f32x4 v0 = acc[ai][bj][m][0], v1 = acc[ai][bj][m][1];
#pragma unroll
                    for (int e = 0; e < 4; ++e) { v0[e] = gelu_tanh(v0[e]); v1[e] = gelu_tanh(v1[e]); }
                    *(u32x4*)(Y + (size_t)(chunk * CH + t) * 512 + u.g * 16 + h) = pack8(v0, v1);
                }
            }
    }
};
struct EpiGlu {
    static constexpr bool PERM = true;
    bf16_t* MIX;
    __device__ __forceinline__ void operator()(const f32x4 (&acc)[2][2][4][2], const Unit& u, int wr, int wc, int fr, int fq) const {
        const int row0 = u.pm * 256 + wr * 64 + fr;
#pragma unroll
        for (int ai = 0; ai < 2; ++ai)
#pragma unroll
            for (int m = 0; m < 4; ++m) {
                const int row = row0 + ai * 128 + m * 16;
#pragma unroll
                for (int bj = 0; bj < 2; ++bj) {
                    const int c = u.pn * 256 + bj * 128 + wc * 32 + 8 * fq;
                    const f32x4 v0 = acc[ai][bj][m][0], v1 = acc[ai][bj][m][1];
                    const float o0 = v0[0] * rcpf(1.0f + ex2(-LOG2E * v0[1])), o1 = v0[2] * rcpf(1.0f + ex2(-LOG2E * v0[3]));
                    const float o2 = v1[0] * rcpf(1.0f + ex2(-LOG2E * v1[1])), o3 = v1[2] * rcpf(1.0f + ex2(-LOG2E * v1[3]));
                    u32x2 w; w.x = pk2(o0, o1); w.y = pk2(o2, o3);
                    *(u32x2*)(MIX + (size_t)row * 1024 + 512 + (c >> 1)) = w;
                }
            }
    }
};
struct EpiRes {
    static constexpr bool PERM = true;
    const float* base32;
    float* out32;
    bf16_t* XN; float* part;
    __device__ __forceinline__ void operator()(const f32x4 (&acc)[2][2][4][2], const Unit& u, int wr, int wc, int fr, int fq) const {
        const int row0 = u.pm * 256 + wr * 64 + fr, col0 = u.pn * 256 + wc * 32 + 8 * fq;
        u32x4 bw[2][4][2];
        if (!base32) {
#pragma unroll
            for (int ai = 0; ai < 2; ++ai)
#pragma unroll
                for (int m = 0; m < 4; ++m)
#pragma unroll
                    for (int bj = 0; bj < 2; ++bj) bw[ai][m][bj] = *(const u32x4*)(XN + (size_t)(row0 + ai * 128 + m * 16) * DM + col0 + bj * 128);
        }
#pragma unroll
        for (int ai = 0; ai < 2; ++ai)
#pragma unroll
            for (int m = 0; m < 4; ++m) {
                const int row = row0 + ai * 128 + m * 16; const size_t off = (size_t)row * DM + col0; float ss = 0.f;
#pragma unroll
                for (int bj = 0; bj < 2; ++bj) {
                    f32x4 b0, b1;
                    if (base32) { b0 = __builtin_nontemporal_load((const f32x4*)(base32 + off + bj * 128)); b1 = __builtin_nontemporal_load((const f32x4*)(base32 + off + bj * 128 + 4)); }
                    else { const u32x4 w = bw[ai][m][bj]; b0 = (f32x4){bflo(w.x), bfhi(w.x), bflo(w.y), bfhi(w.y)}; b1 = (f32x4){bflo(w.z), bfhi(w.z), bflo(w.w), bfhi(w.w)}; }
                    const f32x4 x0 = b0 + acc[ai][bj][m][0], x1 = b1 + acc[ai][bj][m][1];
                    if (out32) { __builtin_nontemporal_store(x0, (f32x4*)(out32 + off + bj * 128)); __builtin_nontemporal_store(x1, (f32x4*)(out32 + off + bj * 128 + 4)); }
                    else *(u32x4*)(XN + off + bj * 128) = pack8(x0, x1);
                    ss += ((x0[0] * x0[0] + x0[1] * x0[1]) + (x0[2] * x0[2] + x0[3] * x0[3])) + ((x1[0] * x1[0] + x1[1] * x1[1]) + (x1[2] * x1[2] + x1[3] * x1[3]));
                }
                ss += __shfl_xor(ss, 16); ss += __shfl_xor(ss, 32);
                if (fq == 0) part[(size_t)row * 16 + u.pn * 4 + wc] = ss;
            }
    }
};
struct EpiFfn1 {
    static constexpr bool PERM = true;
    const LAS float* rsl; bf16_t* HID;
    __device__ __forceinline__ void operator()(const f32x4 (&acc)[2][2][4][2], const Unit& u, int wr, int wc, int fr, int fq) const {
        const int row0 = u.pm * 256 + wr * 64 + fr;
        const __amdgpu_buffer_rsrc_t hid = __builtin_amdgcn_make_buffer_rsrc(HID, 0, NTOK * FF * 2, 0x00020000);
#pragma unroll
        for (int ai = 0; ai < 2; ++ai)
#pragma unroll
            for (int m = 0; m < 4; ++m) {
                const int row = row0 + ai * 128 + m * 16; const float rs = rsl[ai * 128 + wr * 64 + m * 16 + fr];
#pragma unroll
                for (int bj = 0; bj < 2; ++bj) {
                    const int c = u.pn * 256 + bj * 128 + wc * 32 + 8 * fq;
                    f32x4 v0 = acc[ai][bj][m][0] * rs, v1 = acc[ai][bj][m][1] * rs;
#pragma unroll
                    for (int e = 0; e < 4; ++e) { const float a = fmaxf(v0[e], 0.f), b = fmaxf(v1[e], 0.f); v0[e] = a * a; v1[e] = b * b; }
                    __builtin_amdgcn_raw_buffer_store_b128(pack8(v0, v1), hid, (unsigned)(((size_t)row * FF + c) * 2), 0,   16);
                }
            }
    }
};

#define XB_TMO      128
#define XB_XCNT(j)  (256  + 64 * (j))
#define XB_XSUB(j)  (1280 + 64 * (j))
#define XB_XGEN(j)  (2304 + 64 * (j))
#define XB_TOP      3328
#define XB_TOPGEN   3392
#define XCD_BAR_WORDS 3456
#define XB_SPIN_CAP (1u << 22)
__device__ __forceinline__ unsigned xb_ld(unsigned* p)              { return __hip_atomic_load(p, __ATOMIC_RELAXED, __HIP_MEMORY_SCOPE_AGENT); }
__device__ __forceinline__ unsigned xb_add(unsigned* p, unsigned v) { return __hip_atomic_fetch_add(p, v, __ATOMIC_RELAXED, __HIP_MEMORY_SCOPE_AGENT); }
__device__ __forceinline__ unsigned xb_xcc_id() { return (unsigned)__builtin_amdgcn_s_getreg((3 << 11) | 20) & 0xFu; }
#define XB_SPIN(cond, bar) do { unsigned _sp = 0; while (cond) { __builtin_amdgcn_s_sleep(1); \
    if ((++_sp & 255u) == 0u) { if (xb_ld(&(bar)[XB_TMO])) break; if (_sp > XB_SPIN_CAP) { atomicAdd(&(bar)[XB_TMO], 1u); break; } } } } while (0)
struct XcdBarrier { unsigned* bar; unsigned x; volatile LAS unsigned* st; };
__device__ __forceinline__ XcdBarrier xcd_barrier_post(unsigned* bar, volatile LAS unsigned* st) {
    XcdBarrier b; b.bar = bar; b.x = xb_xcc_id(); b.st = st;
    if (threadIdx.x == 0) (void)xb_add(&bar[XB_XCNT(b.x)], 1u);
    return b;
}
__device__ __forceinline__ void xcd_barrier_complete(unsigned* bar, unsigned x, unsigned& nloc, unsigned& nx) {
    const unsigned G = gridDim.x * gridDim.y * gridDim.z;
    unsigned sum, cnt, mine, sp = 0u;
    for (;;) {
        sum = 0u; cnt = 0u; mine = 0u;
#pragma unroll
        for (unsigned j = 0; j < 16; ++j) { const unsigned c = xb_ld(&bar[XB_XCNT(j)]); sum += c; cnt += (c > 0u) ? 1u : 0u; mine = (j == x) ? c : mine; }
        if (sum == G) break;
        __builtin_amdgcn_s_sleep(1);
        if ((++sp & 255u) == 0u) { if (xb_ld(&bar[XB_TMO])) break; if (sp > XB_SPIN_CAP) { atomicAdd(&bar[XB_TMO], 1u); break; } }
    }
    nloc = mine > 0u ? mine : 1u; nx = cnt > 0u ? cnt : 1u;
}
__device__ __forceinline__ void xcd_barrier(const XcdBarrier& b) {
    asm volatile("s_waitcnt vmcnt(0)" ::: "memory");
    __syncthreads();
    if (threadIdx.x == 0) {
        unsigned* bar = b.bar;
        __builtin_amdgcn_s_waitcnt(0);
        unsigned nloc = b.st[0], nx = b.st[1];
        if (nloc == 0u) { xcd_barrier_complete(bar, b.x, nloc, nx); b.st[0] = nloc; b.st[1] = nx; }
        const unsigned old = xb_add(&bar[XB_XSUB(b.x)], 1u);
        const unsigned gen = old / nloc;
        if (old + 1u == (gen + 1u) * nloc) {
            __builtin_amdgcn_fence(__ATOMIC_RELEASE, "agent");
            asm volatile("s_waitcnt vmcnt(0)" ::: "memory");
            const unsigned og = xb_add(&bar[XB_TOP], 1u);
            const unsigned tg = og / nx;
            __builtin_amdgcn_fence(__ATOMIC_ACQUIRE, "agent");
            if (og + 1u == (tg + 1u) * nx) xb_add(&bar[XB_TOPGEN], 1u);
            else XB_SPIN(xb_ld(&bar[XB_TOPGEN]) == tg, bar);
            xb_add(&bar[XB_XGEN(b.x)], 1u);
            asm volatile("s_waitcnt vmcnt(0)" ::: "memory");
        } else {
            __builtin_amdgcn_fence(__ATOMIC_ACQUIRE, "agent");
            XB_SPIN(xb_ld(&bar[XB_XGEN(b.x)]) == gen, bar);
            asm volatile("s_waitcnt vmcnt(0)" ::: "memory");
        }
    }
    __syncthreads();
}

struct Args {
    const float *x, *norm1, *w_in, *q_gain, *k_gain, *sink, *lam_re, *lam_im, *log_dt, *b_re, *b_im, *c_re, *c_im, *d_skip, *w_glu, *w_out, *norm2, *w_ff1, *w_ff2;
    float* out; unsigned char* ws;
};

template <int MODE  >
__device__ __forceinline__ void p0_transpose_item(const float* W, int K, int N, const float* gain, bf16_t* WT, LAS float* scr, int item, int lane) {
    const int nblk = N / 64, kb = item / nblk, nb = item % nblk, k0 = 64 * kb, n0 = 64 * nb;
    const __amdgpu_buffer_rsrc_t wrs = __builtin_amdgcn_make_buffer_rsrc(WT, 0, N * K * 2, 0x00020000);
    const int lr = lane >> 4, lc = 4 * (lane & 15);
    f32x4 v[16];
#pragma unroll
    for (int i = 0; i < 16; ++i) v[i] = __builtin_nontemporal_load((const f32x4*)(W + (size_t)(k0 + 4 * i + lr) * N + n0 + lc));
#pragma unroll
    for (int i = 0; i < 16; ++i) { const int kk = 4 * i + lr; f32x4 x = v[i]; if (gain) x = x * gain[k0 + kk];
        LAS float* s = scr + kk * 65 + lc; s[0] = x[0]; s[1] = x[1]; s[2] = x[2]; s[3] = x[3]; }
    asm volatile("s_waitcnt lgkmcnt(0)" ::: "memory");
#pragma unroll
    for (int j = 0; j < 8; ++j) { const int piece = lane + 64 * j, n = piece >> 3, c = piece & 7; const LAS float* s = scr + (8 * c) * 65 + n;
        u32x4 o; o.x = pk2(s[0 * 65], s[1 * 65]); o.y = pk2(s[2 * 65], s[3 * 65]); o.z = pk2(s[4 * 65], s[5 * 65]); o.w = pk2(s[6 * 65], s[7 * 65]);
        const int nn = n0 + n; const int orow = (MODE == 1) ? (nn < 512 ? 2 * nn : 2 * (nn - 512) + 1) : nn;
        __builtin_amdgcn_raw_buffer_store_b128(o, wrs, (unsigned)((orow * K + k0 + 8 * c) * 2), 0,   16); }
    asm volatile("s_waitcnt lgkmcnt(0)" ::: "memory");
}

__device__ __forceinline__ f32x2 cmul(f32x2 a, f32x2 b) { return (f32x2){a.x * b.x - a.y * b.y, a.x * b.y + a.y * b.x}; }
__device__ __forceinline__ void ssm_gen(LAS unsigned char* lds, const Args& a, int layer, int g, int j8) {
    LAS f32x2* PW = (LAS f32x2*)lds;
    LAS f32x2* BB = PW + 2 * 33 * 64;
    LAS f32x2* CT = BB + 2 * 64 * 16;
    LAS float* KC = (LAS float*)(CT + 2 * 64 * 16);
    constexpr int KCS = 260;
    LAS float* DSK = KC + 2 * 32 * KCS;
    int tid_ = threadIdx.x; asm volatile("" : "+v"(tid_)); const int tid = tid_;
    bf16_t* MST = (bf16_t*)(a.ws + ((layer & 1) ? WS_MST2 : WS_MST)) + (size_t)g * 256 * 512;
    bf16_t* TOUT = (bf16_t*)(a.ws + ((layer & 1) ? WS_TOUT2 : WS_TOUT)) + (size_t)g * 512 * UK;
    f32x2* APOW = (f32x2*)(a.ws + WS_APOW) + (layer & 1) * 4096 + g * 128;
    if (tid < 16) DSK[tid] = a.d_skip[layer * 512 + g * 16 + tid];
    {
        const int p = tid & 63;
        float lrv[2], liv[2], dtv[2];
#pragma unroll
        for (int dir = 0; dir < 2; ++dir) { lrv[dir] = a.lam_re[((layer * 2 + dir) * 32 + g) * 64 + p]; liv[dir] = a.lam_im[((layer * 2 + dir) * 32 + g) * 64 + p]; dtv[dir] = __expf(a.log_dt[(layer * 2 + dir) * 32 + g]); }
#pragma unroll 1
        for (int r = 0; r < 9; ++r) {
            const int idx = tid + 512 * r;
            if (idx < 2 * 33 * 64) {
                const int dir = idx >= 33 * 64 ? 1 : 0, d = (idx - dir * 33 * 64) >> 6;
                const float lr = dir ? lrv[1] : lrv[0], li = dir ? liv[1] : liv[0], dt = dir ? dtv[1] : dtv[0];
                const float mag = __expf(lr * dt * (float)d);
                double rev = (double)li * (double)dt * 0.15915494309189535 * (double)d; rev -= __builtin_rint(rev);
                const float rv = (float)rev;
                PW[idx] = (f32x2){mag * __builtin_amdgcn_cosf(rv), mag * __builtin_amdgcn_sinf(rv)};
            }
        }
#pragma unroll
        for (int r = 0; r < 4; ++r) {
            const int i = tid + 512 * r, dir = i >> 10, pp = (i >> 4) & 63, h = i & 15;
            const float lr = a.lam_re[((layer * 2 + dir) * 32 + g) * 64 + pp], li = a.lam_im[((layer * 2 + dir) * 32 + g) * 64 + pp], dt = dir ? dtv[1] : dtv[0];
            const float mag = __expf(lr * dt);
            double rev = (double)li * (double)dt * 0.15915494309189535; rev -= __builtin_rint(rev);
            const float abx = mag * __builtin_amdgcn_cosf((float)rev), aby = mag * __builtin_amdgcn_sinf((float)rev);
            const float den = lr * lr + li * li;
            const float zr = ((abx - 1.0f) * lr + aby * li) / den, zi = (aby * lr - (abx - 1.0f) * li) / den;
            const float br = a.b_re[(((size_t)layer * 32 + g) * 64 + pp) * 16 + h], bi = a.b_im[(((size_t)layer * 32 + g) * 64 + pp) * 16 + h];
            BB[(dir * 64 + pp) * 16 + h] = (f32x2){zr * br - zi * bi, zr * bi + zi * br};
            const size_t ci = ((((size_t)layer * 2 + dir) * 32 + g) * 16 + h) * 64 + pp;
            CT[(dir * 64 + pp) * 16 + h] = (f32x2){a.c_re[ci], a.c_im[ci]};
        }
    }
    __syncthreads();
    if (j8 == 0 && tid < 128) APOW[tid] = PW[((tid >> 6) * 33 + 32) * 64 + (tid & 63)];
    const int ndf = 4 * j8 + 4;
    {
        const int wv = tid >> 6, l = tid & 63, col = l & 15, kq = l >> 4, part = kq & 1;
#pragma unroll 1
        for (int blk = wv; blk < 36; blk += 8) {
            const int dir = blk < ndf ? 0 : 1, d = dir ? blk - ndf : blk;
            f32x4 acc = {0.f, 0.f, 0.f, 0.f};
#pragma unroll 8
            for (int st = 0; st < 32; ++st) {
                const int p = 2 * st + (kq >> 1);
                const f32x2 c = CT[(dir * 64 + p) * 16 + col], w = PW[(dir * 33 + d) * 64 + p], bb = BB[(dir * 64 + p) * 16 + col];
                const float av = part ? -(c.x * w.y + c.y * w.x) : (c.x * w.x - c.y * w.y);
                const float bv = part ? bb.y : bb.x;
                acc = __builtin_amdgcn_mfma_f32_16x16x4f32(av, bv, acc, 0, 0, 0);
            }
#pragma unroll
            for (int i = 0; i < 4; ++i) KC[(dir * 32 + d) * KCS + (4 * kq + i) * 16 + col] = acc[i];
        }
    }
    __syncthreads();
#pragma unroll 1
    for (int r = 0; r < 12; ++r) {
        const int q = tid + 512 * r, n = 64 * j8 + q / 96, k0 = (q % 96) * 8, t = n >> 4, h = n & 15;
        float v[8];
        if (k0 < 512) {
            const int s = k0 >> 4, h0 = k0 & 15, d = t - s;
            if (d > 0) {
#pragma unroll
                for (int e = 0; e < 8; ++e) v[e] = KC[(0 * 32 + d) * KCS + h * 16 + h0 + e];
            } else if (d < 0) {
#pragma unroll
                for (int e = 0; e < 8; ++e) v[e] = KC[(1 * 32 - d) * KCS + h * 16 + h0 + e];
            } else {
                const float dd = DSK[h];
#pragma unroll
                for (int e = 0; e < 8; ++e) v[e] = KC[(0 * 32) * KCS + h * 16 + h0 + e] + KC[(1 * 32) * KCS + h * 16 + h0 + e] + ((h0 + e) == h ? dd : 0.f);
            }
        } else {
            const int kk = k0 - 512, dir = kk >> 7, reim = (kk >> 6) & 1, p0 = kk & 63, d = dir == 0 ? t + 1 : 32 - t;
#pragma unroll
            for (int e = 0; e < 8; ++e) { const f32x2 w = cmul(CT[(dir * 64 + p0 + e) * 16 + h], PW[(dir * 33 + d) * 64 + p0 + e]); v[e] = reim ? -w.y : w.x; }
        }
        u32x4 o; o.x = pk2(v[0], v[1]); o.y = pk2(v[2], v[3]); o.z = pk2(v[4], v[5]); o.w = pk2(v[6], v[7]);
        __builtin_amdgcn_raw_buffer_store_b128(o, __builtin_amdgcn_make_buffer_rsrc(TOUT, 0, 512 * UK * 2, 0x00020000), (unsigned)((n * UK + k0) * 2), 0,   16);
    }
#pragma unroll 1
    for (int r = 0; r < 4; ++r) {
        const int q = tid + 512 * r, n = 32 * j8 + (q >> 6), k0 = (q & 63) * 8, s = k0 >> 4, h0 = k0 & 15, dir = n >> 7, reim = (n >> 6) & 1, p = n & 63, d = dir == 0 ? 31 - s : s;
        const f32x2 pw = PW[(dir * 33 + d) * 64 + p];
        float v[8];
#pragma unroll
        for (int e = 0; e < 8; ++e) { const f32x2 w = cmul(pw, BB[(dir * 64 + p) * 16 + h0 + e]); v[e] = reim ? w.y : w.x; }
        u32x4 o; o.x = pk2(v[0], v[1]); o.y = pk2(v[2], v[3]); o.z = pk2(v[4], v[5]); o.w = pk2(v[6], v[7]);
        __builtin_amdgcn_raw_buffer_store_b128(o, __builtin_amdgcn_make_buffer_rsrc(MST, 0, 256 * 512 * 2, 0x00020000), (unsigned)((n * 512 + k0) * 2), 0,   16);
    }
    __syncthreads();
}

__device__ __forceinline__ void carry_scan(LAS unsigned char* lds, const Args& a, int g, int b, int par) {
    int tid_ = threadIdx.x; asm volatile("" : "+v"(tid_)); const int tid = tid_;
    const int sp = tid & 127, seg = tid >> 7, dir = sp >> 6, p = sp & 63;
    const f32x2 aL = ((const f32x2*)(a.ws + WS_APOW))[par * 4096 + g * 128 + sp];
    f32x2 a64 = aL;
#pragma unroll
    for (int k = 0; k < 6; ++k) a64 = cmul(a64, a64);
    const float* S = (const float*)(a.ws + WS_S) + ((size_t)g * NCH + b * 256) * 256 + dir * 128 + p;
    bf16_t* U = (bf16_t*)(a.ws + WS_UB) + ((size_t)g * NCH + b * 256) * UK + 512 + dir * 128 + p;
    const int cbeg = dir ? 255 - seg * 64 : seg * 64, cstep = dir ? -1 : 1;
    float tr = 0.f, ti = 0.f;
#pragma unroll 1
    for (int i0 = 0; i0 < 64; i0 += 32) {
        float srv[32], siv[32];
#pragma unroll
        for (int k = 0; k < 32; ++k) { const int c = cbeg + cstep * (i0 + k); srv[k] = S[(size_t)c * 256]; siv[k] = S[(size_t)c * 256 + 64]; }
#pragma unroll
        for (int k = 0; k < 32; ++k) {
            const float nr = aL.x * tr - aL.y * ti + srv[k], ni = aL.x * ti + aL.y * tr + siv[k];
            tr = nr; ti = ni;
        }
    }
    LAS f32x2* TOT = (LAS f32x2*)lds;
    TOT[seg * 128 + sp] = (f32x2){tr, ti};
    __syncthreads();
    float cr = 0.f, ci = 0.f;
    for (int j = 0; j < seg; ++j) { const f32x2 t = TOT[j * 128 + sp]; const float nr = a64.x * cr - a64.y * ci + t.x, ni = a64.x * ci + a64.y * cr + t.y; cr = nr; ci = ni; }
#pragma unroll 1
    for (int i0 = 0; i0 < 64; i0 += 32) {
        float srv[32], siv[32];
#pragma unroll
        for (int k = 0; k < 32; ++k) { const int c = cbeg + cstep * (i0 + k); srv[k] = S[(size_t)c * 256]; siv[k] = S[(size_t)c * 256 + 64]; }
        asm volatile("" ::: "memory");
#pragma unroll
        for (int k = 0; k < 32; ++k) {
            const int c = cbeg + cstep * (i0 + k);
            U[(size_t)c * UK] = (bf16_t)(pk2(cr, 0.f) & 0xffffu); U[(size_t)c * UK + 64] = (bf16_t)(pk2(ci, 0.f) & 0xffffu);
            const float nr = aL.x * cr - aL.y * ci + srv[k], ni = aL.x * ci + aL.y * cr + siv[k];
            cr = nr; ci = ni;
        }
    }
    __syncthreads();
}

constexpr int KS_LD = 72, VT_LD = 388;
__device__ __forceinline__ int crow(int r, int hi) { return (r & 3) + 8 * (r >> 2) + 4 * hi; }
__device__ __forceinline__ void attn_unit(LAS unsigned char* lds, const Args& a, int layer, int b, int nb, int kh, float shift2) {
    int tid_ = threadIdx.x; asm volatile("" : "+v"(tid_)); const int tid = tid_, lane = tid & 63, wid = tid >> 6;
    LAS bf16_t* KS = (LAS bf16_t*)lds;
    LAS bf16_t* VT = (LAS bf16_t*)(lds + 384 * KS_LD * 2);
    const bf16_t* Qb = (const bf16_t*)(a.ws + WS_Q); const bf16_t* Kb = (const bf16_t*)(a.ws + WS_K); const bf16_t* Vb = (const bf16_t*)(a.ws + WS_V);
    bf16_t* MIX = (bf16_t*)(a.ws + WS_MIX);
    const float* qg = a.q_gain + layer * 64; const float* kg = a.k_gain + layer * 64;
    const int hq = kh * 4 + (wid >> 1), n = lane & 31, hi = lane >> 5;
    const int ib = (wid & 1) * 64;
    const size_t tok0 = (size_t)b * SEQ + nb * 128 + ib + n;
    const int part = tid & 7;
    u32x4 kraw[6], vraw[6], qraw[2][4];
#pragma unroll
    for (int r = 0; r < 6; ++r) {
        const int key = (tid >> 3) + 64 * r, pos = (nb - 1) * 128 + key;
        const size_t row = (size_t)b * SEQ + ((pos >= 0 && pos < SEQ) ? pos : 0);
        kraw[r] = *(const u32x4*)(Kb + row * 128 + kh * 64 + part * 8);
        vraw[r] = *(const u32x4*)(Vb + row * 128 + kh * 64 + part * 8);
    }
#pragma unroll
    for (int qt = 0; qt < 2; ++qt)
#pragma unroll
        for (int ks = 0; ks < 4; ++ks) qraw[qt][ks] = *(const u32x4*)(Qb + (tok0 + 32 * qt) * 512 + hq * 64 + ks * 16 + hi * 8);
    const f32x4 kg0 = *(const f32x4*)(kg + part * 8), kg1 = *(const f32x4*)(kg + part * 8 + 4);
#pragma unroll
    for (int r = 0; r < 6; ++r) {
        const int key = (tid >> 3) + 64 * r;
        const u32x4 kr = kraw[r], vr = vraw[r];
        float kf[8] = {bflo(kr.x), bfhi(kr.x), bflo(kr.y), bfhi(kr.y), bflo(kr.z), bfhi(kr.z), bflo(kr.w), bfhi(kr.w)};
        float ss = 0.f;
#pragma unroll
        for (int e = 0; e < 8; ++e) ss += kf[e] * kf[e];
        ss += __shfl_xor(ss, 1); ss += __shfl_xor(ss, 2); ss += __shfl_xor(ss, 4);
        const float sc = __builtin_amdgcn_rsqf(ss * (1.0f / 64.0f) + EPS);
        u32x4 o; o.x = pk2(kf[0] * sc * kg0[0], kf[1] * sc * kg0[1]); o.y = pk2(kf[2] * sc * kg0[2], kf[3] * sc * kg0[3]);
        o.z = pk2(kf[4] * sc * kg1[0], kf[5] * sc * kg1[1]); o.w = pk2(kf[6] * sc * kg1[2], kf[7] * sc * kg1[3]);
        *(LAS u32x4*)(KS + key * KS_LD + part * 8) = o;
        LAS bf16_t* vp = VT + (part * 8) * VT_LD + key;
        vp[0 * VT_LD] = (bf16_t)(vr.x & 0xffffu); vp[1 * VT_LD] = (bf16_t)(vr.x >> 16);
        vp[2 * VT_LD] = (bf16_t)(vr.y & 0xffffu); vp[3 * VT_LD] = (bf16_t)(vr.y >> 16);
        vp[4 * VT_LD] = (bf16_t)(vr.z & 0xffffu); vp[5 * VT_LD] = (bf16_t)(vr.z >> 16);
        vp[6 * VT_LD] = (bf16_t)(vr.w & 0xffffu); vp[7 * VT_LD] = (bf16_t)(vr.w >> 16);
    }
    __syncthreads();
    const float slope2 = ex2(-(float)(hq + 1)) * LOG2E;
    const float sinkterm = ex2(a.sink[layer * 8 + hq] * LOG2E - shift2);
    bf16x8 qf[2][4];
#pragma unroll
    for (int qt = 0; qt < 2; ++qt) {
        u32x4 qr[4]; float ss = 0.f;
#pragma unroll
        for (int ks = 0; ks < 4; ++ks) { qr[ks] = qraw[qt][ks];
#pragma unroll
            for (int e = 0; e < 4; ++e) { const float lo = bflo(qr[ks][e]), hh = bfhi(qr[ks][e]); ss += lo * lo + hh * hh; } }
        ss += __shfl_xor(ss, 32);
        const float sc = __builtin_amdgcn_rsqf(ss * (1.0f / 64.0f) + EPS) * (0.125f * LOG2E);
#pragma unroll
        for (int ks = 0; ks < 4; ++ks) {
            const f32x4 g0 = *(const f32x4*)(qg + ks * 16 + hi * 8), g1 = *(const f32x4*)(qg + ks * 16 + hi * 8 + 4);
            u32x4 o; o.x = pk2(bflo(qr[ks].x) * sc * g0[0], bfhi(qr[ks].x) * sc * g0[1]); o.y = pk2(bflo(qr[ks].y) * sc * g0[2], bfhi(qr[ks].y) * sc * g0[3]);
            o.z = pk2(bflo(qr[ks].z) * sc * g1[0], bfhi(qr[ks].z) * sc * g1[1]); o.w = pk2(bflo(qr[ks].w) * sc * g1[2], bfhi(qr[ks].w) * sc * g1[3]);
            qf[qt][ks] = __builtin_bit_cast(bf16x8, o);
        }
    }
    f32x16 oa0, oa1, ob0, ob1; float la = 0.f, lb = 0.f;
#pragma unroll
    for (int e = 0; e < 16; ++e) { oa0[e] = 0.f; oa1[e] = 0.f; ob0[e] = 0.f; ob1[e] = 0.f; }
    const int kt0 = ib >> 5;
    const float nshift = -shift2;
#pragma unroll 1
    for (int kt = kt0; kt <= kt0 + 9; ++kt) {
        const int gb = nb - 1 + (kt >> 2);
        if (gb < 0 || gb >= SEQ / 128) continue;
        f32x16 sa, sb;
#pragma unroll
        for (int e = 0; e < 16; ++e) { sa[e] = nshift; sb[e] = nshift; }
#pragma unroll
        for (int ks = 0; ks < 4; ++ks) {
            const bf16x8 ka = *(const LAS bf16x8*)(KS + (32 * kt + n) * KS_LD + ks * 16 + hi * 8);
            sa = __builtin_amdgcn_mfma_f32_32x32x16_bf16(ka, qf[0][ks], sa, 0, 0, 0);
            sb = __builtin_amdgcn_mfma_f32_32x32x16_bf16(ka, qf[1][ks], sb, 0, 0, 0);
        }
        const float ea = (float)(32 * kt - (ib + n) - 128 + 4 * hi), eb = ea - 32.0f;
        if (kt <= kt0 + 1 || kt >= kt0 + 8) {
#pragma unroll
            for (int r = 0; r < 16; ++r) {
                const float da = __builtin_fabsf(ea + (float)crow(r, 0)), db = __builtin_fabsf(eb + (float)crow(r, 0));
                const float pa = da <= 128.0f ? ex2(sa[r] - slope2 * da) : 0.f, pb = db <= 128.0f ? ex2(sb[r] - slope2 * db) : 0.f;
                la += pa; lb += pb; sa[r] = pa; sb[r] = pb;
            }
        } else {
#pragma unroll
            for (int r = 0; r < 16; ++r) {
                const float pa = ex2(sa[r] - slope2 * __builtin_fabsf(ea + (float)crow(r, 0))), pb = ex2(sb[r] - slope2 * __builtin_fabsf(eb + (float)crow(r, 0)));
                la += pa; lb += pb; sa[r] = pa; sb[r] = pb;
            }
        }
        u32x4 pa0, pa1, pb0, pb1;
        pa0.x = pk2(sa[0], sa[1]); pa0.y = pk2(sa[2], sa[3]); pa0.z = pk2(sa[4], sa[5]); pa0.w = pk2(sa[6], sa[7]);
        pa1.x = pk2(sa[8], sa[9]); pa1.y = pk2(sa[10], sa[11]); pa1.z = pk2(sa[12], sa[13]); pa1.w = pk2(sa[14], sa[15]);
        pb0.x = pk2(sb[0], sb[1]); pb0.y = pk2(sb[2], sb[3]); pb0.z = pk2(sb[4], sb[5]); pb0.w = pk2(sb[6], sb[7]);
        pb1.x = pk2(sb[8], sb[9]); pb1.y = pk2(sb[10], sb[11]); pb1.z = pk2(sb[12], sb[13]); pb1.w = pk2(sb[14], sb[15]);
        const LAS bf16_t* vb = VT + n * VT_LD + 32 * kt + 4 * hi;
        {
            const s16x4 a0 = *(const LAS s16x4*)(vb), a1 = *(const LAS s16x4*)(vb + 8);
            const s16x4 c0 = *(const LAS s16x4*)(vb + 32 * VT_LD), c1 = *(const LAS s16x4*)(vb + 32 * VT_LD + 8);
            const bf16x8 v0 = __builtin_shufflevector(a0, a1, 0, 1, 2, 3, 4, 5, 6, 7), v1 = __builtin_shufflevector(c0, c1, 0, 1, 2, 3, 4, 5, 6, 7);
            oa0 = __builtin_amdgcn_mfma_f32_32x32x16_bf16(v0, __builtin_bit_cast(bf16x8, pa0), oa0, 0, 0, 0);
            oa1 = __builtin_amdgcn_mfma_f32_32x32x16_bf16(v1, __builtin_bit_cast(bf16x8, pa0), oa1, 0, 0, 0);
            ob0 = __builtin_amdgcn_mfma_f32_32x32x16_bf16(v0, __builtin_bit_cast(bf16x8, pb0), ob0, 0, 0, 0);
            ob1 = __builtin_amdgcn_mfma_f32_32x32x16_bf16(v1, __builtin_bit_cast(bf16x8, pb0), ob1, 0, 0, 0);
        }
        {
            const s16x4 a0 = *(const LAS s16x4*)(vb + 16), a1 = *(const LAS s16x4*)(vb + 24);
            const s16x4 c0 = *(const LAS s16x4*)(vb + 32 * VT_LD + 16), c1 = *(const LAS s16x4*)(vb + 32 * VT_LD + 24);
            const bf16x8 v0 = __builtin_shufflevector(a0, a1, 0, 1, 2, 3, 4, 5, 6, 7), v1 = __builtin_shufflevector(c0, c1, 0, 1, 2, 3, 4, 5, 6, 7);
            oa0 = __builtin_amdgcn_mfma_f32_32x32x16_bf16(v0, __builtin_bit_cast(bf16x8, pa1), oa0, 0, 0, 0);
            oa1 = __builtin_amdgcn_mfma_f32_32x32x16_bf16(v1, __builtin_bit_cast(bf16x8, pa1), oa1, 0, 0, 0);
            ob0 = __builtin_amdgcn_mfma_f32_32x32x16_bf16(v0, __builtin_bit_cast(bf16x8, pb1), ob0, 0, 0, 0);
            ob1 = __builtin_amdgcn_mfma_f32_32x32x16_bf16(v1, __builtin_bit_cast(bf16x8, pb1), ob1, 0, 0, 0);
        }
    }
    la += __shfl_xor(la, 32); lb += __shfl_xor(lb, 32);
    const float inva = 1.0f / (la + sinkterm), invb = 1.0f / (lb + sinkterm);
    bf16_t* opa = MIX + tok0 * 1024 + hq * 64 + 4 * hi; bf16_t* opb = opa + 32 * 1024;
#pragma unroll
    for (int j = 0; j < 4; ++j) {
        u32x2 w0, w1, w2, w3;
        w0.x = pk2(oa0[4 * j] * inva, oa0[4 * j + 1] * inva); w0.y = pk2(oa0[4 * j + 2] * inva, oa0[4 * j + 3] * inva);
        w1.x = pk2(oa1[4 * j] * inva, oa1[4 * j + 1] * inva); w1.y = pk2(oa1[4 * j + 2] * inva, oa1[4 * j + 3] * inva);
        w2.x = pk2(ob0[4 * j] * invb, ob0[4 * j + 1] * invb); w2.y = pk2(ob0[4 * j + 2] * invb, ob0[4 * j + 3] * invb);
        w3.x = pk2(ob1[4 * j] * invb, ob1[4 * j + 1] * invb); w3.y = pk2(ob1[4 * j + 2] * invb, ob1[4 * j + 3] * invb);
        *(u32x2*)(opa + 8 * j) = w0; *(u32x2*)(opa + 32 + 8 * j) = w1; *(u32x2*)(opb + 8 * j) = w2; *(u32x2*)(opb + 32 + 8 * j) = w3;
    }
    __syncthreads();
}

__global__ void __launch_bounds__(512, 2) mk_fwd(Args a) {
    extern __shared__ __attribute__((aligned(16))) unsigned char lds_raw[];
    LAS unsigned char* lds = (LAS unsigned char*)lds_raw;
    cg::grid_group grid = cg::this_grid();
    const int G = gridDim.x;
    if (threadIdx.x < 2) ((volatile LAS unsigned*)(lds + LDS_BARST))[threadIdx.x] = 0u;
    __syncthreads();
    if (a.ws == nullptr) grid.sync();
    const XcdBarrier xbar = xcd_barrier_post((unsigned*)(a.ws + WS_BAR), (volatile LAS unsigned*)(lds + LDS_BARST));

    {
        int tid_ = threadIdx.x, bx_ = blockIdx.x; asm volatile("" : "+v"(tid_)); asm volatile("" : "+s"(bx_));
        const int tid = tid_, lane = tid & 63, wave = tid >> 6, bx = bx_, layer = 0; (void)tid;
        unsigned char* ws = a.ws;
        bf16_t* WIN = (bf16_t*)(ws + WS_WIN); bf16_t* XN = (bf16_t*)(ws + WS_XN); float* PART = (float*)(ws + WS_PART);
        {
            if (bx >= 192) {
                ssm_gen(lds, a, layer, bx >> 3, bx & 7);
                LAS float* scr = (LAS float*)(lds + wave * 16640);
                constexpr int I_IN = (DM / 64) * (INW / 64);
                for (int it = (bx - 192) * 8 + wave; it < I_IN; it += 64 * 8) p0_transpose_item<0>(a.w_in + (size_t)layer * DM * INW, DM, INW, a.norm1 + layer * DM, WIN, scr, it, lane);
            } else {
                const int gw = bx * 8 + wave, NGW = 192 * 8;
                for (int m0 = gw * 4; m0 < NTOK; m0 += NGW * 4) {
                    f32x4 v[4][4];
#pragma unroll
                    for (int q = 0; q < 4; ++q)
#pragma unroll
                        for (int j = 0; j < 4; ++j) v[q][j] = __builtin_nontemporal_load((const f32x4*)(a.x + (size_t)(m0 + q) * DM) + lane + 64 * j);
#pragma unroll
                    for (int q = 0; q < 4; ++q) {
                        float ss = 0.f; unsigned long long* o8 = (unsigned long long*)(XN + (size_t)(m0 + q) * DM) + lane;
#pragma unroll
                        for (int j = 0; j < 4; ++j) { const f32x4 w = v[q][j]; ss += (w.x * w.x + w.y * w.y) + (w.z * w.z + w.w * w.w);
                            o8[64 * j] = (unsigned long long)pk2(w.x, w.y) | ((unsigned long long)pk2(w.z, w.w) << 32); }
#pragma unroll
                        for (int o = 1; o < 64; o <<= 1) ss += __shfl_xor(ss, o);
                        if (lane < 16) PART[(size_t)(m0 + q) * 16 + lane] = lane == 0 ? ss : 0.f;
                    }
                }
            }
        }
        GSYNC();
    }
#pragma unroll 1
    for (int layer = 0; layer < DEPTH; ++layer) {
        int tid_ = threadIdx.x, bx_ = blockIdx.x; asm volatile("" : "+v"(tid_)); asm volatile("" : "+s"(bx_));
        const int tid = tid_, lane = tid & 63, wave = tid >> 6, bx = bx_; (void)tid;
        const int par = layer & 1;
        unsigned char* ws = a.ws; asm volatile("" : "+s"(ws));
        bf16_t* WGLU = (bf16_t*)(ws + WS_WGLU); bf16_t* WOUT = (bf16_t*)(ws + WS_WOUT); bf16_t* W1 = (bf16_t*)(ws + WS_W1); bf16_t* W2 = (bf16_t*)(ws + WS_W2);
        bf16_t* XN = (bf16_t*)(ws + WS_XN); bf16_t* HID = (bf16_t*)(ws + WS_HID); bf16_t* MIX = (bf16_t*)(ws + WS_MIX); bf16_t* YB = (bf16_t*)(ws + WS_Y); bf16_t* UB = (bf16_t*)(ws + WS_UB);
        float* PART = (float*)(ws + WS_PART);
        bf16_t* WIN = (bf16_t*)(ws + (par ? WS_WIN2 : WS_WIN)); bf16_t* WINN = (bf16_t*)(ws + (par ? WS_WIN : WS_WIN2));
        for (int rp = 0; rp < REP_P1; ++rp) {
            pg8::Gemm g{XN, WIN, DM, DM, DM, 0, 0}; pg8::StaticOrder S; S.init(NTOK, INW, G, bx);
            LAS float* rsl = (LAS float*)(lds + 131072);
            Unit u0, u1; int pm0 = 0;
            pg8::RsPre pre{PART, rsl, 0, 0, 0};
            if (S.next(0, u0)) { pm0 = u0.pm; const bool two = S.next(1, u1); pre.pm0 = u0.pm; pre.pm1 = two ? u1.pm : u0.pm; pre.ntab = two ? 2 : 1; }
            EpiInProj E{rsl, pm0, (bf16_t*)(ws + WS_Q), (bf16_t*)(ws + WS_K), (bf16_t*)(ws + WS_V), UB};
            pg8::gemm_phase<EpiInProj, pg8::StaticOrder, true, true, pg8::RsPre>(lds, g, S, E, pre);
            if (bx >= 64 && rp == 0) {
                LAS float* scr = (LAS float*)(lds + wave * 16640);
                const int gw = (bx - 64) * 8 + wave, NGW = (G - 64) * 8;
                constexpr int I_GLU = (512 / 64) * (1024 / 64), I_OUT = (DM / 64) * (DM / 64), I_1 = (DM / 64) * (FF / 64), I_2 = (FF / 64) * (DM / 64);
                for (int it = gw; it < I_GLU + I_OUT + I_1 + I_2; it += NGW) {
                    int r = it;
                    if (r < I_GLU) { p0_transpose_item<1>(a.w_glu + (size_t)layer * 512 * 1024, 512, 1024, nullptr, WGLU, scr, r, lane); continue; } r -= I_GLU;
                    if (r < I_OUT) { p0_transpose_item<0>(a.w_out + (size_t)layer * DM * DM, DM, DM, nullptr, WOUT, scr, r, lane); continue; } r -= I_OUT;
                    if (r < I_1) { p0_transpose_item<0>(a.w_ff1 + (size_t)layer * DM * FF, DM, FF, a.norm2 + layer * DM, W1, scr, r, lane); continue; } r -= I_1;
                    p0_transpose_item<0>(a.w_ff2 + (size_t)layer * FF * DM, FF, DM, nullptr, W2, scr, r, lane);
                }
                if (layer + 1 < DEPTH) for (int it = gw; it < (DM / 64) * (INW / 64); it += NGW) p0_transpose_item<0>(a.w_in + (size_t)(layer + 1) * DM * INW, DM, INW, a.norm1 + (layer + 1) * DM, WINN, scr, it, lane);
                __syncthreads(); ssm_gen(lds, a, layer, (bx - 64) >> 3, (bx - 64) & 7);
            }
        }
        GSYNC();
        {
#define ATTN_SHIFT2(var) float var; { int ln_ = threadIdx.x & 63; asm volatile("" : "+v"(ln_)); float mq = fabsf(a.q_gain[layer * 64 + ln_]), mk = fabsf(a.k_gain[layer * 64 + ln_]); \
            _Pragma("unroll") for (int o = 1; o < 64; o <<= 1) { mq = fmaxf(mq, __shfl_xor(mq, o)); mk = fmaxf(mk, __shfl_xor(mk, o)); } var = 8.0f * mq * mk * LOG2E; }
            unsigned* flags = (unsigned*)(ws + WS_FLAG);
            const unsigned epoch = (unsigned)layer + 1u;
            if (bx < 64) {
                pg8::Gemm g{UB, (const bf16_t*)(ws + (par ? WS_MST2 : WS_MST)), UK, 512, 512, (size_t)NCH * UK, (size_t)256 * 512};
                const int cm = (bx & 7) * 8 + (bx >> 3);
                pg8::BatchOrder S{64, cm, 64, 2, 1};
                EpiState E{(float*)(ws + WS_S)};
                pg8::gemm_phase<EpiState, pg8::BatchOrder>(lds, g, S, E);
                asm volatile("s_waitcnt vmcnt(0)" ::: "memory"); __syncthreads();
                carry_scan(lds, a, cm >> 1, cm & 1, par);
                asm volatile("s_waitcnt vmcnt(0)" ::: "memory"); __syncthreads();
                if (tid == 0) { __builtin_amdgcn_fence(__ATOMIC_RELEASE, "agent"); asm volatile("s_waitcnt vmcnt(0)" ::: "memory"); __hip_atomic_store(flags + 64 * cm, epoch, __ATOMIC_RELAXED, __HIP_MEMORY_SCOPE_AGENT); }
                { const int u = 192 + (bx & 7) * 8 + (bx >> 3); ATTN_SHIFT2(shift2); attn_unit(lds, a, layer, u >> 7, (u >> 1) & 63, u & 1, shift2); }
            } else if (bx < 192) {
                const int v = bx - 64;
                { const int u = (v & 7) * 16 + (v >> 3); ATTN_SHIFT2(shift2); attn_unit(lds, a, layer, u >> 7, (u >> 1) & 63, u & 1, shift2); }
                const int cs = (v & 7) * 16 + (v >> 3);
                pg8::Gemm g{UB, (const bf16_t*)(ws + (par ? WS_TOUT2 : WS_TOUT)), UK, UK, UK, (size_t)NCH * UK, (size_t)512 * UK};
                pg8::GatedBatchOrder S; S.G = 128; S.c = cs; S.total = 128; S.npm = 2; S.npn = 2; S.flag = flags + 64 * ((cs >> 2) * 2 + ((cs >> 1) & 1)); S.epoch = epoch;
                EpiSsmOut E{YB};
                pg8::gemm_phase<EpiSsmOut, pg8::GatedBatchOrder>(lds, g, S, E);
            } else {
                { const int v = bx - 192, u = 128 + (v & 7) * 8 + (v >> 3); ATTN_SHIFT2(shift2); attn_unit(lds, a, layer, u >> 7, (u >> 1) & 63, u & 1, shift2); }
                if (layer + 1 < DEPTH) ssm_gen(lds, a, layer + 1, bx >> 3, bx & 7);
            }
        }
        GSYNC();
        for (int rp = 0; rp < REP_P5; ++rp) {
            pg8::Gemm g{YB, WGLU, 512, 512, 512, 0, 0}; pg8::StaticOrder S; S.init(NTOK, 1024, G, bx);
            EpiGlu E{MIX};
            pg8::gemm_phase<EpiGlu, pg8::StaticOrder>(lds, g, S, E);
        }
        GSYNC();
        {
            pg8::Gemm g{MIX, WOUT, DM, DM, DM, 0, 0}; pg8::StaticOrder S; S.init(NTOK, DM, G, bx);
            EpiRes E{layer == 0 ? a.x : nullptr, nullptr, XN, PART};
            pg8::gemm_phase<EpiRes, pg8::StaticOrder>(lds, g, S, E);
        }
        GSYNC();
        for (int rp = 0; rp < REP_P7; ++rp) {
            pg8::Gemm g{XN, W1, DM, DM, DM, 0, 0}; pg8::StaticOrder S; S.init(NTOK, FF, G, bx);
            LAS float* rsl = (LAS float*)(lds + 131072);
            pg8::RsPre pre{PART, rsl, 0, 0, 0};
            { Unit u0; if (S.next(0, u0)) { pre.pm0 = u0.pm; pre.ntab = 1; } }
            EpiFfn1 E{rsl, HID};
            pg8::gemm_phase<EpiFfn1, pg8::StaticOrder, true, true, pg8::RsPre>(lds, g, S, E, pre);
        }
        GSYNC();
        {
            pg8::Gemm g{HID, W2, FF, FF, FF, 0, 0}; pg8::StaticOrder S; S.init(NTOK, DM, G, bx);
            EpiRes E{nullptr, layer == DEPTH - 1 ? a.out : nullptr, XN, PART};
            pg8::gemm_phase<EpiRes, pg8::StaticOrder>(lds, g, S, E);
        }
        if (layer + 1 < DEPTH) GSYNC();
    }
}

extern "C" void kernel_launch(void* const* d_in, const int* in_sizes, int n_in, void* d_out, int out_size, void* d_ws, size_t ws_size, hipStream_t stream) {
    static int grid = 0;
    if (grid == 0) {
        if (n_in != 19 || in_sizes[0] != NTOK * DM || out_size != NTOK * DM || ws_size < WS_END) { fprintf(stderr, "kernel_launch: unexpected shapes (n_in %d, ws %zu)\n", n_in, ws_size); grid = -1; return; }
        int dev = 0, cus = 0, per_cu = 0;
        hipGetDevice(&dev); hipDeviceGetAttribute(&cus, hipDeviceAttributeMultiprocessorCount, dev);
        if (hipFuncSetAttribute((const void*)mk_fwd, hipFuncAttributeMaxDynamicSharedMemorySize, LDS_BYTES) != hipSuccess) { fprintf(stderr, "kernel_launch: hipFuncSetAttribute failed\n"); grid = -1; return; }
        if (hipOccupancyMaxActiveBlocksPerMultiprocessor(&per_cu, (const void*)mk_fwd, 512, LDS_BYTES) != hipSuccess || per_cu < 1) { fprintf(stderr, "kernel_launch: occupancy query gives %d\n", per_cu); per_cu = 1; }
        (void)hipGetLastError();
        if (cus < 256) { fprintf(stderr, "kernel_launch: built for a 256-CU device, found %d CUs\n", cus); grid = -1; return; }
        grid = 256;
    }
    if (grid < 0) return;
    if (hipMemsetAsync((char*)d_ws, 0, 131072, stream) != hipSuccess) { fprintf(stderr, "kernel_launch: memset failed\n"); return; }
    Args a{};
    const float** ap = (const float**)&a;
    for (int i = 0; i < 19; ++i) ap[i] = (const float*)d_in[i];
    a.out = (float*)d_out; a.ws = (unsigned char*)d_ws;
    void* args[] = {&a};
    hipError_t e = hipLaunchCooperativeKernel((const void*)mk_fwd, dim3(grid), dim3(512), args, LDS_BYTES, stream);
    if (e != hipSuccess) fprintf(stderr, "cooperative launch failed: %s (grid %d)\n", hipGetErrorString(e), grid);
}
```
